# Optimizing an MI355X kernel written in HIP

```python
import jax, jax.numpy as jnp
from jax import lax
import numpy as np

D_MODEL = 1024
BATCH = 16
SEQ = 2048
DEPTH = 4

HEAD_DIM = 64
POOL_WIDTH = D_MODEL // 2
POOL_WINDOWS = (2, 4, 8, 16)
POOL_GROUPS = len(POOL_WINDOWS)
POOL_GROUP_DIM = POOL_WIDTH // POOL_GROUPS
CONV_WIDTH = D_MODEL // 2
CONV_K = 3
EVEN_IN = POOL_WIDTH + 3 * CONV_WIDTH
EVEN_CAT = POOL_WIDTH + CONV_WIDTH
C_HEADS = (D_MODEL // 2) // HEAD_DIM
C_PATTERNS = ((128, 1), (512, 4), (2048, 16))
D_HEADS = (D_MODEL // 2) // HEAD_DIM
D_KV_HEADS = 2
D_GROUP = D_HEADS // D_KV_HEADS
D_RADIUS = 128
C_WIDTH = C_HEADS * HEAD_DIM
D_Q_WIDTH = D_HEADS * HEAD_DIM
D_KV_WIDTH = D_KV_HEADS * HEAD_DIM
ODD_IN = 3 * C_WIDTH + D_Q_WIDTH + 2 * D_KV_WIDTH
ODD_CAT = C_WIDTH + D_Q_WIDTH
N_EXPERTS = 32
TOP_K = 4
D_EXPERT = D_MODEL
SWIGLU_LIMIT = 7.0
SWIGLU_ALPHA = 1.702
MOE_BLOCK = 256
N_EVEN = (DEPTH + 1) // 2
N_ODD = DEPTH // 2
DEEPNORM_ALPHA = (2 * DEPTH) ** 0.25
DEEPNORM_BETA = (8 * DEPTH) ** -0.25
LN_EPS = 1e-5
NEG_INF = -1e30

kernel_name = 'hybrid_pool_conv_dilated_swa_moe_encoder'


def split_cols(h, sizes):
    return jnp.split(h, [int(i) for i in np.cumsum(sizes)[:-1]], axis=-1)


def layer_norm(x, g, b):
    xf = x.astype(jnp.float32)
    mu = jnp.mean(xf, axis=-1, keepdims=True)
    xc = xf - mu
    var = jnp.mean(xc * xc, axis=-1, keepdims=True)
    y = xc * lax.rsqrt(var + LN_EPS) * g.astype(jnp.float32) + b.astype(jnp.float32)
    return y.astype(x.dtype)


def alibi_slopes(n):
    return jnp.asarray([2.0 ** (-8.0 * (i + 1) / n) for i in range(n)], jnp.float32)


def pool_mixer(u, pool_w, pool_scale):
    b_, s_, _ = u.shape
    uf = u.astype(jnp.float32)
    cs = jnp.concatenate([jnp.zeros_like(uf[:, :1]), jnp.cumsum(uf, axis=1)], axis=1)
    t = jnp.arange(s_)
    outs = []
    for g, w in enumerate(POOL_WINDOWS):
        sl = slice(g * POOL_GROUP_DIM, (g + 1) * POOL_GROUP_DIM)
        lo = jnp.clip(t - w // 2, 0, s_)
        hi = jnp.clip(t + w - w // 2, 0, s_)
        csg = cs[..., sl]
        win_sum = jnp.take(csg, hi, axis=1) - jnp.take(csg, lo, axis=1)
        cnt = (hi - lo).astype(jnp.float32)[None, :, None]
        outs.append(win_sum / cnt - uf[..., sl])
    pooled = jnp.stack(outs, axis=2).astype(u.dtype)
    mixed = jnp.einsum('bsgc,gcd->bsgd', pooled, pool_w).reshape(b_, s_, POOL_WIDTH)
    return mixed * pool_scale


def short_conv_mixer(b_gate, c_gate, v, conv_w):
    u = c_gate * v
    s_ = u.shape[1]
    half = CONV_K // 2
    up = jnp.pad(u, ((0, 0), (half, CONV_K - 1 - half), (0, 0)))
    conv = up[:, 0:s_] * conv_w[0]
    for k in range(1, CONV_K):
        conv = conv + up[:, k:k + s_] * conv_w[k]
    return b_gate * conv


def even_mixer(x, w_in, pool_w, pool_scale, conv_w, w_out):
    h = x @ w_in
    a_in, b_gate, c_gate, v = split_cols(h, (POOL_WIDTH, CONV_WIDTH, CONV_WIDTH, CONV_WIDTH))
    ya = pool_mixer(a_in, pool_w, pool_scale)
    yb = short_conv_mixer(b_gate, c_gate, v, conv_w)
    return jnp.concatenate([ya, yb], axis=-1) @ w_out


def banded_attention(q, k, v, radius, slopes, dist_unit):
    n_, l_, hkv, g_, hd = q.shape
    nb = -(-l_ // radius)
    lp = nb * radius
    pad = lp - l_
    qb = jnp.pad(q, ((0, 0), (0, pad), (0, 0), (0, 0), (0, 0))).reshape(n_, nb, radius, hkv, g_, hd)

    def key_span(t):
        tp = jnp.pad(t, ((0, 0), (radius, radius + pad), (0, 0), (0, 0)))
        tb = tp.reshape(n_, nb + 2, radius, hkv, hd)
        return jnp.concatenate([tb[:, :-2], tb[:, 1:-1], tb[:, 2:]], axis=2)

    kb, vb = key_span(k), key_span(v)
    q_pos = jnp.arange(lp).reshape(nb, radius)
    k_pos = jnp.arange(nb)[:, None] * radius - radius + jnp.arange(3 * radius)[None, :]
    dist = jnp.abs(k_pos[:, None, :] - q_pos[:, :, None])
    valid = (dist <= radius) & (k_pos >= 0)[:, None, :] & (k_pos < l_)[:, None, :]
    s = jnp.einsum('nbqhgd,nbkhd->nbhgqk', qb, kb).astype(jnp.float32) * (hd ** -0.5)
    s = s - slopes[None, None, :, :, None, None] * (dist * dist_unit).astype(jnp.float32)[None, :, None, None]
    s = jnp.where(valid[None, :, None, None], s, NEG_INF)
    lse = jax.nn.logsumexp(s, axis=-1)
    p = jnp.exp(s - lse[..., None]).astype(v.dtype)
    o = jnp.einsum('nbhgqk,nbkhd->nbqhgd', p, vb).reshape(n_, lp, hkv, g_, hd)[:, :l_]
    lse = lse.transpose(0, 1, 4, 2, 3).reshape(n_, lp, hkv, g_)[:, :l_]
    return o, lse


def dilated_attention(q, k, v):
    b_, s_, h_, hd = q.shape
    slopes = alibi_slopes(h_)[:, None]
    outs, lses = [], []
    for window, dil in C_PATTERNS:
        radius = window // 2 // dil
        l_ = s_ // dil

        def to_sub(t):
            return t.reshape(b_, l_, dil, h_, hd).transpose(0, 2, 1, 3, 4).reshape(b_ * dil, l_, h_, hd)

        o, lse = banded_attention(to_sub(q)[:, :, :, None], to_sub(k), to_sub(v), radius, slopes, dil)
        outs.append(o.reshape(b_, dil, l_, h_, hd).transpose(0, 2, 1, 3, 4).reshape(b_, s_, h_, hd))
        lses.append(lse.reshape(b_, dil, l_, h_).transpose(0, 2, 1, 3).reshape(b_, s_, h_))
    w = jax.nn.softmax(jnp.stack(lses, axis=0), axis=0).astype(q.dtype)
    return jnp.sum(w[..., None] * jnp.stack(outs, axis=0), axis=0)


def odd_mixer(x, w_in, sink, w_out):
    b_, s_, _ = x.shape
    h = x @ w_in
    qc, kc, vc, qd, kd, vd = split_cols(h, (C_WIDTH, C_WIDTH, C_WIDTH, D_Q_WIDTH, D_KV_WIDTH, D_KV_WIDTH))
    heads = lambda t, n: t.reshape(b_, s_, n, HEAD_DIM)
    yc = dilated_attention(heads(qc, C_HEADS), heads(kc, C_HEADS), heads(vc, C_HEADS)).reshape(b_, s_, C_WIDTH)
    od, lse = banded_attention(qd.reshape(b_, s_, D_KV_HEADS, D_GROUP, HEAD_DIM),
                               heads(kd, D_KV_HEADS), heads(vd, D_KV_HEADS), D_RADIUS,
                               alibi_slopes(D_HEADS).reshape(D_KV_HEADS, D_GROUP), 1)
    sink_gate = jax.nn.sigmoid(lse - sink.astype(jnp.float32).reshape(D_KV_HEADS, D_GROUP))
    yd = (od * sink_gate[..., None].astype(od.dtype)).reshape(b_, s_, D_Q_WIDTH)
    return jnp.concatenate([yc, yd], axis=-1) @ w_out


def moe_ffn(x, router_w, router_b, w_gu, b_gu, w_down, b_down):
    b_, s_, d_ = x.shape
    t_ = b_ * s_
    xt = x.reshape(t_, d_)
    logits = (xt @ router_w).astype(jnp.float32) + router_b.astype(jnp.float32)
    top_logits, top_idx = lax.top_k(logits, TOP_K)
    gates = jax.nn.softmax(top_logits, axis=-1)
    a_ = t_ * TOP_K
    flat_e = top_idx.reshape(a_)
    order = jnp.argsort(flat_e)
    e_sorted = flat_e[order]
    counts = jnp.bincount(flat_e, length=N_EXPERTS)
    padded = (counts + MOE_BLOCK - 1) // MOE_BLOCK * MOE_BLOCK
    pad_end = jnp.cumsum(padded)
    grp_start = jnp.cumsum(counts) - counts
    dest = (pad_end - padded)[e_sorted] + jnp.arange(a_) - grp_start[e_sorted]
    n_blocks = -(-a_ // MOE_BLOCK) + N_EXPERTS
    rows = n_blocks * MOE_BLOCK
    slot_tok = jnp.full((rows,), t_, jnp.int32).at[dest].set((order // TOP_K).astype(jnp.int32))
    slot_gate = jnp.zeros((rows,), jnp.float32).at[dest].set(gates.reshape(a_)[order])
    block_e = jnp.minimum(jnp.searchsorted(pad_end, jnp.arange(n_blocks) * MOE_BLOCK, side='right'), N_EXPERTS - 1)
    x_rows = jnp.concatenate([xt, jnp.zeros((1, d_), xt.dtype)], axis=0)[slot_tok].reshape(n_blocks, MOE_BLOCK, d_)

    def expert_block(args):
        xb, e = args
        h = xb @ w_gu[e] + b_gu[e]
        glu = jnp.minimum(h[:, 0::2], SWIGLU_LIMIT)
        lin = jnp.clip(h[:, 1::2], -SWIGLU_LIMIT, SWIGLU_LIMIT)
        act = glu * jax.nn.sigmoid(SWIGLU_ALPHA * glu) * (lin + 1.0)
        return act @ w_down[e] + b_down[e]

    y = lax.map(expert_block, (x_rows, block_e)).reshape(rows, d_)
    y = y * slot_gate[:, None].astype(y.dtype)
    out = jnp.zeros((t_ + 1, d_), y.dtype).at[slot_tok].add(y)[:t_]
    return out.reshape(b_, s_, d_)


def setup_inputs(seed: int = 0) -> dict:
    key = jax.random.key(seed)
    ks = jax.random.split(key, 17)

    def normal(k, shape, scale):
        return jax.random.normal(k, shape, jnp.float32) * scale

    return {
        'x': normal(ks[0], (BATCH, SEQ, D_MODEL), 1.0),
        'ev_w_in': normal(ks[1], (N_EVEN, D_MODEL, EVEN_IN), D_MODEL ** -0.5),
        'ev_pool_w': normal(ks[2], (N_EVEN, POOL_GROUPS, POOL_GROUP_DIM, POOL_GROUP_DIM), POOL_GROUP_DIM ** -0.5),
        'ev_pool_scale': 1.0 + normal(ks[3], (N_EVEN, POOL_WIDTH), 0.1),
        'ev_conv_w': normal(ks[4], (N_EVEN, CONV_K, CONV_WIDTH), CONV_K ** -0.5),
        'ev_w_out': normal(ks[5], (N_EVEN, EVEN_CAT, D_MODEL), DEEPNORM_BETA * EVEN_CAT ** -0.5),
        'od_w_in': normal(ks[6], (N_ODD, D_MODEL, ODD_IN), D_MODEL ** -0.5),
        'od_sink': normal(ks[7], (N_ODD, D_HEADS), 1.0),
        'od_w_out': normal(ks[8], (N_ODD, ODD_CAT, D_MODEL), DEEPNORM_BETA * ODD_CAT ** -0.5),
        'router_w': normal(ks[9], (DEPTH, D_MODEL, N_EXPERTS), D_MODEL ** -0.5),
        'router_b': normal(ks[10], (DEPTH, N_EXPERTS), 0.01),
        'exp_w_gu': normal(ks[11], (DEPTH, N_EXPERTS, D_MODEL, 2 * D_EXPERT), D_MODEL ** -0.5),
        'exp_b_gu': normal(ks[12], (DEPTH, N_EXPERTS, 2 * D_EXPERT), 0.02),
        'exp_w_down': normal(ks[13], (DEPTH, N_EXPERTS, D_EXPERT, D_MODEL), DEEPNORM_BETA * D_EXPERT ** -0.5),
        'exp_b_down': normal(ks[14], (DEPTH, N_EXPERTS, D_MODEL), 0.02),
        'ln_g': 1.0 + normal(ks[15], (DEPTH, 2, D_MODEL), 0.02),
        'ln_b': normal(ks[16], (DEPTH, 2, D_MODEL), 0.02),
    }


def reference(x, ev_w_in, ev_pool_w, ev_pool_scale, ev_conv_w, ev_w_out, od_w_in, od_sink, od_w_out,
              router_w, router_b, exp_w_gu, exp_b_gu, exp_w_down, exp_b_down, ln_g, ln_b):
    for layer in range(DEPTH):
        i = layer // 2
        if layer % 2 == 0:
            mix = even_mixer(x, ev_w_in[i], ev_pool_w[i], ev_pool_scale[i], ev_conv_w[i], ev_w_out[i])
        else:
            mix = odd_mixer(x, od_w_in[i], od_sink[i], od_w_out[i])
        x = layer_norm(DEEPNORM_ALPHA * x + mix, ln_g[layer, 0], ln_b[layer, 0])
        ffn = moe_ffn(x, router_w[layer], router_b[layer], exp_w_gu[layer], exp_b_gu[layer],
                      exp_w_down[layer], exp_b_down[layer])
        x = layer_norm(DEEPNORM_ALPHA * x + ffn, ln_g[layer, 1], ln_b[layer, 1])
    return x
```

```cpp
#include <hip/hip_runtime.h>
#include <cstdio>
#include <cstdint>
#include <type_traits>

#ifndef MK_N_LAUNCHES
#define MK_N_LAUNCHES 1
#endif

#ifndef PROBE_REP_PH
#define PROBE_REP_PH (-1)
#endif
#define NREP(k) ((PROBE_REP_PH == (k)) ? 2 : 1)
#define LAS __attribute__((address_space(3)))
typedef unsigned short bf16_t;
typedef short bf16x8 __attribute__((ext_vector_type(8)));
typedef float f32x4 __attribute__((ext_vector_type(4)));
typedef unsigned u32x4 __attribute__((ext_vector_type(4)));
typedef unsigned u32x2 __attribute__((ext_vector_type(2)));
typedef int i32x4 __attribute__((ext_vector_type(4)));
typedef int i32x8 __attribute__((ext_vector_type(8)));

constexpr int BATCH = 16, SEQ = 2048, D = 1024, T = BATCH * SEQ, DEPTH = 4;
constexpr int EVEN_IN = 2048, ODD_IN = 2304, NEXP = 32, TOPK = 4;
constexpr float ALPHA = 1.6817928305074292f;
constexpr float LN_EPS = 1e-5f;
constexpr int NWAVES = 8;
constexpr int PH_PER_LAYER = 7, N_PHASES = 1 + DEPTH * PH_PER_LAYER;

constexpr size_t MiB = 1u << 20;
constexpr size_t WS_CTL = 0, CTL_ZERO_BYTES = 64 * 1024;
constexpr size_t WS_EVIN = 2 * MiB;
constexpr size_t WS_EVOUT = 10 * MiB;
constexpr size_t WS_ODIN = 14 * MiB;
constexpr size_t WS_ODOUT = 24 * MiB;
constexpr size_t WS_WGU = 32 * MiB;
constexpr size_t WS_SB = 288 * MiB;
constexpr size_t WS_SBIN = 289 * MiB;
constexpr size_t WS_SX = 289 * MiB + 512 * 1024;
constexpr size_t WS_XQ = 290 * MiB;
constexpr size_t WS_SBD = 332 * MiB;
constexpr size_t WS_SXS = 326 * MiB;
constexpr size_t WS_WDN = 544 * MiB;
constexpr size_t WS_XB = 800 * MiB;
constexpr size_t WS_H = 864 * MiB;
constexpr size_t WS_CAT = 1008 * MiB;
constexpr size_t WS_Y = 1072 * MiB;
constexpr size_t WS_ACT = 1136 * MiB;
constexpr size_t WS_YS = 1408 * MiB;
constexpr size_t WS_LIST = 1680 * MiB;
constexpr size_t WS_INFO = 1684 * MiB;
constexpr size_t WS_END = 1688 * MiB;
constexpr int CW_BAR = 4096, CW_CNT = 8192;

constexpr int RING_BYTES = 131072;
constexpr int MISC_OFF = RING_BYTES;
constexpr int TAB_OFF = RING_BYTES + 64;
constexpr int LDS_BYTES = 147456;

typedef float f32x2_t __attribute__((ext_vector_type(2)));
typedef __bf16 bf16x2_t __attribute__((ext_vector_type(2)));
__device__ __forceinline__ unsigned cvt_pk_bf16(float lo, float hi) { const f32x2_t v = {lo, hi}; const bf16x2_t b = __builtin_convertvector(v, bf16x2_t); return __builtin_bit_cast(unsigned, b); }
__device__ __forceinline__ float bf_lo(unsigned w) { return __uint_as_float(w << 16); }
__device__ __forceinline__ float bf_hi(unsigned w) { return __uint_as_float(w & 0xffff0000u); }
__device__ __forceinline__ void unpack8(const u32x4 w, float (&f)[8]) { f[0] = bf_lo(w.x); f[1] = bf_hi(w.x); f[2] = bf_lo(w.y); f[3] = bf_hi(w.y); f[4] = bf_lo(w.z); f[5] = bf_hi(w.z); f[6] = bf_lo(w.w); f[7] = bf_hi(w.w); }
__device__ __forceinline__ void unpack8_f8(const u32x2 w, float (&f)[8]) {
    typedef float f32x2v __attribute__((ext_vector_type(2)));
    const f32x2v a = __builtin_amdgcn_cvt_pk_f32_fp8((int)w.x, false), b = __builtin_amdgcn_cvt_pk_f32_fp8((int)w.x, true), c = __builtin_amdgcn_cvt_pk_f32_fp8((int)w.y, false), d = __builtin_amdgcn_cvt_pk_f32_fp8((int)w.y, true);
    f[0] = a.x; f[1] = a.y; f[2] = b.x; f[3] = b.y; f[4] = c.x; f[5] = c.y; f[6] = d.x; f[7] = d.y;
}
__device__ __forceinline__ u32x4 pack8(const float (&f)[8]) { u32x4 o; o.x = cvt_pk_bf16(f[0], f[1]); o.y = cvt_pk_bf16(f[2], f[3]); o.z = cvt_pk_bf16(f[4], f[5]); o.w = cvt_pk_bf16(f[6], f[7]); return o; }
__device__ __forceinline__ int lane_id() { unsigned ones = ~0u; asm volatile("" : "+s"(ones)); return (int)__builtin_amdgcn_mbcnt_hi(ones, __builtin_amdgcn_mbcnt_lo(ones, 0u)); }
template <int O> __device__ __forceinline__ float xor_sw(float v) { return __int_as_float(__builtin_amdgcn_ds_swizzle(__float_as_int(v), 0x1f | (O << 10))); }
__device__ __forceinline__ float sum_x32(float v) { const auto r = __builtin_amdgcn_permlane32_swap(__float_as_uint(v), __float_as_uint(v), false, false); return __uint_as_float(r[0]) + __uint_as_float(r[1]); }
__device__ __forceinline__ float max_x32(float v) { const auto r = __builtin_amdgcn_permlane32_swap(__float_as_uint(v), __float_as_uint(v), false, false); return fmaxf(__uint_as_float(r[0]), __uint_as_float(r[1])); }
template <int CTRL> __device__ __forceinline__ float dpp_f(float v) { return __int_as_float(__builtin_amdgcn_update_dpp(0, __float_as_int(v), CTRL, 0xf, 0xf, true)); }
__device__ __forceinline__ float wave_sum(float v) { v += dpp_f<0xB1>(v); v += dpp_f<0x4E>(v); v += dpp_f<0x141>(v); v += dpp_f<0x140>(v); v += xor_sw<16>(v); return sum_x32(v); }
__device__ __forceinline__ float wave_max(float v) { v = fmaxf(v, dpp_f<0xB1>(v)); v = fmaxf(v, dpp_f<0x4E>(v)); v = fmaxf(v, dpp_f<0x141>(v)); v = fmaxf(v, dpp_f<0x140>(v)); v = fmaxf(v, xor_sw<16>(v)); return max_x32(v); }
__device__ __forceinline__ unsigned q8x4(float a, float b, float c, float d, float inv) {
    const unsigned t0 = __float_as_uint(__builtin_fmaf(a, inv, 12582912.0f)), t1 = __float_as_uint(__builtin_fmaf(b, inv, 12582912.0f));
    const unsigned t2 = __float_as_uint(__builtin_fmaf(c, inv, 12582912.0f)), t3 = __float_as_uint(__builtin_fmaf(d, inv, 12582912.0f));
    return __builtin_amdgcn_perm(__builtin_amdgcn_perm(t3, t2, 0x0c0c0400u), __builtin_amdgcn_perm(t1, t0, 0x0c0c0400u), 0x05040100u);
}
__device__ __forceinline__ unsigned f8x4(float a, float b, float c, float d, float inv) {
    int w = __builtin_amdgcn_cvt_pk_fp8_f32(a * inv, b * inv, 0, false); w = __builtin_amdgcn_cvt_pk_fp8_f32(c * inv, d * inv, w, true); return (unsigned)w;
}
#define XB_TMO      128
#define XB_XCNT(j)  (256  + 64 * (j))
#define XB_XSUB(j)  (1280 + 64 * (j))
#define XB_XGEN(j)  (2304 + 64 * (j))
#define XB_TOP      3328
#define XB_TOPGEN   3392
#define XCD_BAR_WORDS 3456
#define XB_SPIN_CAP (1u << 18)

__device__ __forceinline__ unsigned xb_ld(unsigned* p)              { return __hip_atomic_load(p, __ATOMIC_RELAXED, __HIP_MEMORY_SCOPE_AGENT); }
__device__ __forceinline__ unsigned xb_add(unsigned* p, unsigned v) { return __hip_atomic_fetch_add(p, v, __ATOMIC_RELAXED, __HIP_MEMORY_SCOPE_AGENT); }
__device__ __forceinline__ unsigned xb_xcc_id() { return (unsigned)__builtin_amdgcn_s_getreg((3 << 11) | 20) & 0xFu; }
#define XB_SPIN(cond, bar) do { unsigned _sp = 0; while (cond) { __builtin_amdgcn_s_sleep(1); \
    if ((++_sp & 255u) == 0u) { if (xb_ld(&(bar)[XB_TMO])) break; if (_sp > XB_SPIN_CAP) { atomicAdd(&(bar)[XB_TMO], 1u); break; } } } } while (0)

struct XcdBarrier { unsigned* bar; unsigned x; volatile LAS unsigned* st; };

__device__ __forceinline__ XcdBarrier xcd_barrier_post(unsigned* bar, volatile LAS unsigned* st) {
    XcdBarrier b; b.bar = bar; b.x = xb_xcc_id(); b.st = st;
    if (threadIdx.x == 0) (void)xb_add(&bar[XB_XCNT(b.x)], 1u);
    return b;
}
__device__ __forceinline__ void xcd_barrier_complete(unsigned* bar, unsigned x, unsigned& nloc, unsigned& nx) {
    const unsigned G = gridDim.x * gridDim.y * gridDim.z;
    unsigned sum, cnt, mine, sp = 0u;
    for (;;) {
        sum = 0u; cnt = 0u; mine = 0u;
#pragma unroll
        for (unsigned j = 0; j < 16; ++j) { const unsigned c = xb_ld(&bar[XB_XCNT(j)]); sum += c; cnt += (c > 0u) ? 1u : 0u; mine = (j == x) ? c : mine; }
        if (sum == G) break;
        __builtin_amdgcn_s_sleep(1);
        if ((++sp & 255u) == 0u) { if (xb_ld(&bar[XB_TMO])) break; if (sp > XB_SPIN_CAP) { atomicAdd(&bar[XB_TMO], 1u); break; } }
    }
    nloc = mine > 0u ? mine : 1u; nx = cnt > 0u ? cnt : 1u;
}
__device__ __forceinline__ void xcd_barrier(const XcdBarrier& b, int wave_s) {
    asm volatile("s_waitcnt vmcnt(0)" ::: "memory");
    __syncthreads();
    if (wave_s == 0 && lane_id() == 0) {
        unsigned* bar = b.bar; asm volatile("" : "+s"(bar));
        const unsigned bx_ = xb_xcc_id();
        __builtin_amdgcn_s_waitcnt(0);
        unsigned nloc = b.st[0], nx = b.st[1];
        if (nloc == 0u) { xcd_barrier_complete(bar, bx_, nloc, nx); b.st[0] = nloc; b.st[1] = nx; }
        const unsigned old = xb_add(&bar[XB_XSUB(bx_)], 1u);
        const unsigned gen = old / nloc;
        if (old + 1u == (gen + 1u) * nloc) {
            __builtin_amdgcn_fence(__ATOMIC_RELEASE, "agent");
            asm volatile("s_waitcnt vmcnt(0)" ::: "memory");
            const unsigned og = xb_add(&bar[XB_TOP], 1u);
            const unsigned tg = og / nx;
            if (og + 1u == (tg + 1u) * nx) xb_add(&bar[XB_TOPGEN], 1u);
            else XB_SPIN(xb_ld(&bar[XB_TOPGEN]) == tg, bar);
            __builtin_amdgcn_fence(__ATOMIC_ACQUIRE, "agent");
            xb_add(&bar[XB_XGEN(bx_)], 1u);
            asm volatile("s_waitcnt vmcnt(0)" ::: "memory");
        } else {
            XB_SPIN(xb_ld(&bar[XB_XGEN(bx_)]) == gen, bar);
            __builtin_amdgcn_fence(__ATOMIC_ACQUIRE, "agent");
            asm volatile("s_waitcnt vmcnt(0)" ::: "memory");
        }
    }
    __syncthreads();
}

namespace pg8 {
constexpr int BM = 256, BK = 64, HALF = 128, HTB = HALF * BK * 2, STAGE_BYTES = 8 * HTB, NXCD = 8, WGM = 8, K = 1024;
__device__ __forceinline__ int lds_byte(int r, int c) { const int st = (r >> 4) * 2 + (c >> 5), rr = r & 15, cc = c & 31, ob = rr * 64 + cc * 2; return st * 1024 + (ob ^ (((ob >> 9) & 1) << 5)); }
__device__ __forceinline__ void stage_rc(int b, int& R, int& C) { const int st = b / 1024, sb = b % 1024, swz = sb ^ (((sb >> 9) & 1) << 5); R = (st >> 1) * 16 + swz / 64; C = (st & 1) * 32 + (swz % 64) / 2; }
__device__ __forceinline__ int perm32(int rho) { const int n = rho >> 4, i = rho & 15; return 8 * (i >> 2) + 4 * n + (i & 3); }

struct Unit { int pm, pn, e, aux; };

template <bool I8_> struct DenseSched {
    static constexpr bool GATHER = false;
    static constexpr int RPB = I8_ ? 1024 : 2048;
    const char* A; const char* Bt; int nM, nN, nwg, G, c;
    __device__ __forceinline__ void init(const void* A_, const void* Bt_, int M, int N, int G_, int c_) { A = (const char*)A_; Bt = (const char*)Bt_; nM = M / BM; nN = N / BM; nwg = nM * nN; G = G_; c = c_; }
    __device__ __forceinline__ bool next(int i, Unit& u) const {
        const long L = (long)i * G + c; if (L >= nwg) return false;
        int wgid = (int)L; { const int q = nwg / NXCD, r = nwg % NXCD, xcd = wgid % NXCD, off = wgid / NXCD; wgid = (xcd < r ? xcd * (q + 1) : r * (q + 1) + (xcd - r) * q) + off; }
        const int nig = WGM * nN, gid = wgid / nig, fm = gid * WGM, gsz = (nM - fm) < WGM ? (nM - fm) : WGM;
        u.pm = fm + ((wgid % nig) % gsz); u.pn = (wgid % nig) / gsz; u.e = 0; u.aux = 0; return true;
    }
    __device__ __forceinline__ const char* aptr(const Unit& u) const { return A + (size_t)u.pm * (size_t)(BM * RPB); }
    __device__ __forceinline__ const char* bptr(const Unit& u) const { return Bt + (size_t)u.pn * (size_t)(BM * RPB); }
    __device__ __forceinline__ void gather(const Unit&, unsigned (&)[2][2], int) const {}
    __device__ __forceinline__ const int* list_src(const Unit&) const { return nullptr; }
    __device__ __forceinline__ void gather_lds(const Unit&, unsigned (&)[2][2], int, const LAS unsigned char*) const {}
};
template <bool GATHER_, bool I8_> struct MoeSched {
    static constexpr bool GATHER = GATHER_;
    static constexpr int RPB = I8_ ? 1024 : 2048;
    const char* A; const char* Bt; const int* list; const LAS int* tb; const LAS int* cn; int NN, total, G, vcu;
    __device__ __forceinline__ bool next(int i, Unit& u) const {
        const int L = i * G + vcu; if (L >= total) return false;
        const int mt = L / NN; u.pn = L - mt * NN; u.pm = mt;
        int e = 0;
        for (int j = 1; j < NEXP; ++j) e += (tb[j] <= mt) ? 1 : 0;
        u.e = e; u.aux = mt - tb[e]; return true;
    }
    __device__ __forceinline__ const char* aptr(const Unit& u) const { return GATHER ? A : A + (size_t)u.pm * (size_t)(BM * RPB); }
    __device__ __forceinline__ const char* bptr(const Unit& u) const { return Bt + ((size_t)u.e * NN + u.pn) * (size_t)(BM * RPB); }
    __device__ __forceinline__ const int* list_src(const Unit& u) const { return list + (size_t)u.e * T + u.aux * BM; }
    __device__ __forceinline__ void gather_lds(const Unit& u, unsigned (&g)[2][2], int tid, const LAS unsigned char* tokbuf) const {
        tid = (tid & ~63) | lane_id();
        const int c = cn[u.e] - u.aux * BM; const LAS int* tl = (const LAS int*)tokbuf;
#pragma unroll
        for (int i = 0; i < 2; ++i) { int R, C; stage_rc(tid * 16 + i * 8192, R, C);
#pragma unroll
            for (int h = 0; h < 2; ++h) { int r = h * HALF + R; r = r < c ? r : 0; g[h][i] = (unsigned)(tl[r] * RPB + C * 2); } }
    }
    __device__ __forceinline__ void gather(const Unit& u, unsigned (&g)[2][2], int tid) const {
        tid = (tid & ~63) | lane_id();
        const int c = cn[u.e];
#pragma unroll
        for (int i = 0; i < 2; ++i) { int R, C; stage_rc(tid * 16 + i * 8192, R, C);
#pragma unroll
            for (int h = 0; h < 2; ++h) { int slot = u.aux * BM + h * HALF + R; slot = slot < c ? slot : 0; const int tok = list[(size_t)u.e * T + slot]; g[h][i] = (unsigned)(tok * RPB + C * 2); } }
    }
};

template <int MODE  > struct EpiBf16 {
    static constexpr bool PERM = true, PREFETCH = (MODE == 3 || MODE == 0);
    __device__ __forceinline__ void prefetch(const Unit& u, LAS unsigned char* ebuf, int wid, int lane) const {
        if (MODE == 3) {
            if (wid == 1) __builtin_amdgcn_global_load_lds((const unsigned*)(bias + (size_t)u.e * D + 256 * u.pn + 4 * lane), (LAS unsigned*)(ebuf), 16, 0, 0);
            if (wid == 2) __builtin_amdgcn_global_load_lds((const unsigned*)(sb + (size_t)u.e * D + 256 * u.pn + 4 * lane), (LAS unsigned*)(ebuf + 1024), 16, 0, 0); }
        if (MODE == 0) {
            if (wid == 1) __builtin_amdgcn_global_load_lds((const unsigned*)(sb + 256 * u.pn + 4 * lane), (LAS unsigned*)(ebuf + 1024), 16, 0, 0);
            if (wid == 2) __builtin_amdgcn_global_load_lds((const unsigned*)(sa + 256 * u.pm + 4 * lane), (LAS unsigned*)(ebuf + 2048), 16, 0, 0); }
    }
    bf16_t* O; int ldc; const bf16_t* res; const float* bias; float alpha;
    const float* sa; const float* sb;
    __device__ __forceinline__ void operator()(const i32x4 (&acc)[2][2][4][2], const Unit& u, int wr, int wc, int fr, int fq, const LAS unsigned char* ebuf) const {
        { const int l2 = lane_id(); fr = l2 & 15; fq = l2 >> 4; }
        const int row0 = u.pm * BM + wr * 64 + fr, col0 = u.pn * BM + wc * 32 + 8 * fq;
        f32x4 sv[2][2];
#pragma unroll
        for (int bj = 0; bj < 2; ++bj)
#pragma unroll
            for (int n = 0; n < 2; ++n) sv[bj][n] = (MODE == 0) ? *(const LAS f32x4*)(ebuf + 1024 + 4 * (64 * wc + 16 * fq + 8 * bj + 4 * n)) : *(const f32x4*)(sb + col0 + bj * HALF + 4 * n);
        float rsv[2][4];
#pragma unroll
        for (int ai = 0; ai < 2; ++ai)
#pragma unroll
            for (int m = 0; m < 4; ++m) rsv[ai][m] = (MODE == 0) ? ((const LAS float*)ebuf)[512 + wr * 64 + fr + ai * HALF + m * 16] : sa[row0 + ai * HALF + m * 16];
#pragma unroll
        for (int ai = 0; ai < 2; ++ai)
#pragma unroll
            for (int m = 0; m < 4; ++m) { const int row = row0 + ai * HALF + m * 16; const float rs = rsv[ai][m]; const size_t ro = (size_t)row * ldc + col0;
#pragma unroll
                for (int bj = 0; bj < 2; ++bj) { float v[8];
#pragma unroll
                    for (int i = 0; i < 4; ++i) { v[i] = (float)acc[ai][bj][m][0][i] * (rs * sv[bj][0][i]); v[4 + i] = (float)acc[ai][bj][m][1][i] * (rs * sv[bj][1][i]); }
                    if (MODE == 0) *(u32x4*)(O + (size_t)row * ldc + u.pn * BM + 64 * wc + 16 * fq + 8 * bj) = pack8(v);
                    else *(u32x4*)(O + ro + bj * HALF) = pack8(v); } }
    }
    __device__ __forceinline__ void operator()(const f32x4 (&acc)[2][2][4][2], const Unit& u, int wr, int wc, int fr, int fq, const LAS unsigned char* ebuf) const {
        { const int l2 = lane_id(); fr = l2 & 15; fq = l2 >> 4; }
        const int row0 = u.pm * BM + wr * 64 + fr, col0 = u.pn * BM + wc * 32 + 8 * fq;
        f32x4 bv[2][2];
#pragma unroll
        for (int bj = 0; bj < 2; ++bj)
#pragma unroll
            for (int n = 0; n < 2; ++n) bv[bj][n] = (MODE == 3) ? *(const LAS f32x4*)(ebuf + 4 * (64 * wc + 16 * fq + 8 * bj + 4 * n)) * 16.0f
                                                  : (MODE == 2) ? *(const f32x4*)(bias + (size_t)u.e * D + col0 + bj * HALF + 4 * n) : (f32x4){0.f, 0.f, 0.f, 0.f};
        f32x4 cs[2][2];
#pragma unroll
        for (int bj = 0; bj < 2; ++bj)
#pragma unroll
            for (int n = 0; n < 2; ++n) cs[bj][n] = (MODE == 3) ? *(const LAS f32x4*)(ebuf + 1024 + 4 * (64 * wc + 16 * fq + 8 * bj + 4 * n))
                                                  : (MODE == 2) ? *(const f32x4*)(sb + (size_t)u.e * D + col0 + bj * HALF + 4 * n) : (f32x4){1.f, 1.f, 1.f, 1.f};
#pragma unroll
        for (int ai = 0; ai < 2; ++ai) {
            u32x4 rr[4][2];
            if (MODE == 1) {
#pragma unroll
                for (int m = 0; m < 4; ++m)
#pragma unroll
                    for (int bj = 0; bj < 2; ++bj) rr[m][bj] = *(const u32x4*)(res + (size_t)(row0 + ai * HALF + m * 16) * ldc + col0 + bj * HALF); }
#pragma unroll
            for (int m = 0; m < 4; ++m) { const size_t ro = (size_t)(row0 + ai * HALF + m * 16) * ldc + col0;
                u32x2 w8a;
#pragma unroll
                for (int bj = 0; bj < 2; ++bj) { f32x4 v0 = acc[ai][bj][m][0], v1 = acc[ai][bj][m][1];
                    if (MODE >= 2) { v0 = v0 * cs[bj][0]; v1 = v1 * cs[bj][1]; }
                    v0 += bv[bj][0]; v1 += bv[bj][1];
                    if (MODE == 1) { const u32x4 r = rr[m][bj];
                        v0[0] += alpha * bf_lo(r.x); v0[1] += alpha * bf_hi(r.x); v0[2] += alpha * bf_lo(r.y); v0[3] += alpha * bf_hi(r.y);
                        v1[0] += alpha * bf_lo(r.z); v1[1] += alpha * bf_hi(r.z); v1[2] += alpha * bf_lo(r.w); v1[3] += alpha * bf_hi(r.w); }
                    if (MODE == 3) { u32x2 w8; w8.x = f8x4(v0[0], v0[1], v0[2], v0[3], 1.0f); w8.y = f8x4(v1[0], v1[1], v1[2], v1[3], 1.0f);
                        if (bj == 0) w8a = w8;
                        else { u32x4 w16; w16.x = w8a.x; w16.y = w8a.y; w16.z = w8.x; w16.w = w8.y;
                            *(u32x4*)((unsigned char*)O + (size_t)(row0 + ai * HALF + m * 16) * ldc + u.pn * BM + 64 * wc + 16 * fq) = w16; } }
                    else { u32x4 w; w.x = cvt_pk_bf16(v0[0], v0[1]); w.y = cvt_pk_bf16(v0[2], v0[3]); w.z = cvt_pk_bf16(v1[0], v1[1]); w.w = cvt_pk_bf16(v1[2], v1[3]);
                        *(u32x4*)(O + ro + bj * HALF) = w; } } } }
    }
};
struct EpiSwiGLU {
    static constexpr bool PERM = false, PREFETCH = true;
    __device__ __forceinline__ void prefetch(const Unit& u, LAS unsigned char* ebuf, int wid, int lane) const {
        if (wid == 1) __builtin_amdgcn_global_load_lds((const unsigned*)(bias + (size_t)u.e * 2048 + 256 * u.pn + 4 * lane), (LAS unsigned*)(ebuf), 16, 0, 0);
        if (wid == 2) __builtin_amdgcn_global_load_lds((const unsigned*)(sb + (size_t)u.e * 2048 + 256 * u.pn + 4 * lane), (LAS unsigned*)(ebuf + 1024), 16, 0, 0);
        if (wid == 3) __builtin_amdgcn_global_load_lds((const unsigned*)(sxs + (size_t)u.e * T + u.aux * BM + 4 * lane), (LAS unsigned*)(ebuf + 2048), 16, 0, 0);
    }
    bf16_t* O; const float* bias;
    const float* sb; const float* sxs;
    __device__ __forceinline__ void operator()(const i32x4 (&acc)[2][2][4][2], const Unit& u, int wr, int wc, int fr, int fq, const LAS unsigned char* ebuf) const {
        { const int l2 = lane_id(); fr = l2 & 15; fq = l2 >> 4; }
        const int row0 = u.pm * BM + wr * 64 + fr;
        float rs[2][4];
#pragma unroll
        for (int ai = 0; ai < 2; ++ai)
#pragma unroll
            for (int m = 0; m < 4; ++m) rs[ai][m] = ((const LAS float*)ebuf)[512 + ai * HALF + wr * 64 + m * 16 + fr];
        int wst[2][4];
#pragma unroll
        for (int bj = 0; bj < 2; ++bj) {
            const int g32l = 4 * bj + wc, j0l = 32 * wc + 8 * fq + 4 * bj, j0 = 128 * u.pn + 32 * wc + 8 * fq;
            const f32x4 b0 = *(const LAS f32x4*)(ebuf + 8 * j0l), b1 = *(const LAS f32x4*)(ebuf + 8 * j0l + 16);
            const float bg[4] = {b0[0], b0[2], b1[0], b1[2]}, bl[4] = {b0[1] + 1.0f, b0[3] + 1.0f, b1[1] + 1.0f, b1[3] + 1.0f};
            const f32x4 sg = *(const LAS f32x4*)(ebuf + 1024 + 4 * (32 * g32l + 4 * fq)), sl = *(const LAS f32x4*)(ebuf + 1024 + 4 * (32 * g32l + 16 + 4 * fq));
            typedef float f32x2v __attribute__((ext_vector_type(2)));
            const f32x2v sg2[2] = {{sg[0], sg[1]}, {sg[2], sg[3]}}, sl2[2] = {{sl[0], sl[1]}, {sl[2], sl[3]}}, bg2[2] = {{bg[0], bg[1]}, {bg[2], bg[3]}}, bl2[2] = {{bl[0], bl[1]}, {bl[2], bl[3]}};
#pragma unroll
            for (int ai = 0; ai < 2; ++ai)
#pragma unroll
                for (int m = 0; m < 4; ++m) { float a[4]; const float rsm = rs[ai][m];
#pragma unroll
                    for (int h2 = 0; h2 < 2; ++h2) {
                        const f32x2v ga = {(float)acc[ai][bj][m][0][2 * h2], (float)acc[ai][bj][m][0][2 * h2 + 1]}, la = {(float)acc[ai][bj][m][1][2 * h2], (float)acc[ai][bj][m][1][2 * h2 + 1]};
                        f32x2v g = ga * (sg2[h2] * rsm) + bg2[h2], l = la * (sl2[h2] * rsm) + bl2[h2];
                        g.x = fminf(g.x, 7.0f); g.y = fminf(g.y, 7.0f); l.x = fminf(fmaxf(l.x, -6.0f), 8.0f); l.y = fminf(fmaxf(l.y, -6.0f), 8.0f);
                        const f32x2v z = g * (-1.702f * 1.4426950408889634f);
                        f32x2v den; den.x = __builtin_amdgcn_exp2f(z.x); den.y = __builtin_amdgcn_exp2f(z.y); den = den + 1.0f;
                        f32x2v r; r.x = __builtin_amdgcn_rcpf(den.x); r.y = __builtin_amdgcn_rcpf(den.y);
                        const f32x2v o = (g * r) * l;
                        a[2 * h2] = o.x; a[2 * h2 + 1] = o.y; }
                    int w = __builtin_amdgcn_cvt_pk_fp8_f32(a[0], a[1], 0, false); w = __builtin_amdgcn_cvt_pk_fp8_f32(a[2], a[3], w, true);
                    if (bj == 0) wst[ai][m] = w;
                    else { u32x2 w2; w2.x = (unsigned)wst[ai][m]; w2.y = (unsigned)w; *(u32x2*)((unsigned char*)O + (size_t)(row0 + ai * HALF + m * 16) * D + j0) = w2; } }
        }
    }
    __device__ __forceinline__ void operator()(const f32x4 (&acc)[2][2][4][2], const Unit& u, int wr, int wc, int fr, int fq, const LAS unsigned char* ebuf) const {
        { const int l2 = lane_id(); fr = l2 & 15; fq = l2 >> 4; }
        const int row0 = u.pm * BM + wr * 64 + fr;
#pragma unroll
        for (int bj = 0; bj < 2; ++bj) {
            const int j0 = 16 * (8 * u.pn + 4 * bj + wc) + 4 * fq;
            const f32x4 b0 = *(const f32x4*)(bias + (size_t)u.e * 2048 + 2 * j0), b1 = *(const f32x4*)(bias + (size_t)u.e * 2048 + 2 * j0 + 4);
            const float bg[4] = {b0[0], b0[2], b1[0], b1[2]}, bl[4] = {b0[1], b0[3], b1[1], b1[3]};
#pragma unroll
            for (int ai = 0; ai < 2; ++ai)
#pragma unroll
                for (int m = 0; m < 4; ++m) { float a[4];
#pragma unroll
                    for (int i = 0; i < 4; ++i) { float g = acc[ai][bj][m][0][i] + bg[i], l = acc[ai][bj][m][1][i] + bl[i];
                        g = fminf(g, 7.0f); l = fminf(fmaxf(l, -7.0f), 7.0f);
                        const float sg = __builtin_amdgcn_rcpf(1.0f + __expf(-1.702f * g));
                        a[i] = g * sg * (l + 1.0f); }
                    u32x2 w; w.x = cvt_pk_bf16(a[0], a[1]); w.y = cvt_pk_bf16(a[2], a[3]);
                    *(u32x2*)(O + (size_t)(row0 + ai * HALF + m * 16) * D + j0) = w; }
        }
    }
};

__device__ __forceinline__ f32x4 mma16(bf16x8 a, bf16x8 b, f32x4 c) { return __builtin_amdgcn_mfma_f32_16x16x32_bf16(a, b, c, 0, 0, 0); }
__device__ __forceinline__ i32x4 mma16(bf16x8 a, bf16x8 b, i32x4 c) { return __builtin_amdgcn_mfma_i32_16x16x64_i8(__builtin_bit_cast(i32x4, a), __builtin_bit_cast(i32x4, b), c, 0, 0, 0); }
struct NoHook { __device__ __forceinline__ void operator()(int) const {} };
template <int DT  , class Epi, class Sched, class Hook = NoHook>
__device__ __forceinline__ void gemm_phase(LAS unsigned char* lds, const Sched& S, const Epi& E, int wave_s, LAS unsigned char* aux  ,
                                           const Hook& H = Hook()  ) {
    constexpr bool GATHER = Sched::GATHER;
    constexpr int RPB = DT ? 1024 : 2048;
    typedef typename std::conditional<DT == 1, i32x4, f32x4>::type acc_t;
    int lane_ = lane_id(); asm volatile("" : "+v"(lane_));
    asm volatile("" : "+s"(wave_s));
    const int tid = wave_s * 64 + lane_;
    const int wid = wave_s, lane = tid & 63, wr = wid >> 2, wc = wid & 3, fr = lane & 15, fq = lane >> 4;
    constexpr int nt = RPB / 128;
    unsigned voffA[2], voffB[2];
#pragma unroll
    for (int i = 0; i < 2; ++i) { int R, C; stage_rc(tid * 16 + i * 8192, R, C); const int Rb = Epi::PERM ? ((R & ~31) + perm32(R & 31)) : R;
        voffA[i] = (unsigned)(R * RPB + C * 2); voffB[i] = (unsigned)(Rb * RPB + C * 2); }
    constexpr size_t kstep = (size_t)(BK * 2);
    constexpr size_t hstep = (size_t)HALF * RPB;
    const unsigned ldsw = (unsigned)wid * 1024u;
    const int aoff = lds_byte(wr * 64 + fr, fq * 8), boff = lds_byte(wc * 32 + fr, fq * 8);
    unsigned gA[2][2] = {{0u, 0u}, {0u, 0u}};
#define PG8_SA(b, h) (((b) * 2 + (h)) * HTB)
#define PG8_SB(b, h) ((4 + (b) * 2 + (h)) * HTB)
#define PG8_STAGE(bufoff, gbase, voff) do { _Pragma("unroll") for (int _i = 0; _i < 2; ++_i) \
        __builtin_amdgcn_global_load_lds((const unsigned*)((const char*)(gbase) + (voff)[_i]), (LAS unsigned*)(lds + (bufoff) + ldsw + _i * 8192), 16, 0, 0); } while (0)
#define PG8_STAGE_A(bufoff, h, abase) do { _Pragma("unroll") for (int _i = 0; _i < 2; ++_i) { \
        const char* _src = GATHER ? ((const char*)(abase) + gA[h][_i]) : ((const char*)(abase) + (size_t)(h) * hstep + voffA[_i]); \
        __builtin_amdgcn_global_load_lds((const unsigned*)_src, (LAS unsigned*)(lds + (bufoff) + ldsw + _i * 8192), 16, 0, 0); } } while (0)
#define PG8_LD2(dst, off) do { if constexpr (DT == 2) { const i32x4 _lo = *(const LAS i32x4*)(lds + (off)), _hi = *(const LAS i32x4*)(lds + (off) + 1024); (dst).f8 = __builtin_shufflevector(_lo, _hi, 0, 1, 2, 3, 4, 5, 6, 7); } \
        else { (dst).h[0] = *(const LAS bf16x8*)(lds + (off)); (dst).h[1] = *(const LAS bf16x8*)(lds + (off) + 1024); } } while (0)
#define PG8_LDA(dst, b, h) do { _Pragma("unroll") for (int m = 0; m < 4; ++m) PG8_LD2(dst[m], PG8_SA(b, h) + aoff + m * 2048); } while (0)
#define PG8_LDB(dst, b, h) do { _Pragma("unroll") for (int n = 0; n < 2; ++n) PG8_LD2(dst[n], PG8_SB(b, h) + boff + n * 2048); } while (0)
#define PG8_MMA(ai, bj, At, Bt) do { __builtin_amdgcn_s_setprio(1); _Pragma("unroll") for (int m = 0; m < 4; ++m) _Pragma("unroll") for (int n = 0; n < 2; ++n) { \
        if constexpr (DT == 2) acc[ai][bj][m][n] = __builtin_amdgcn_mfma_scale_f32_16x16x128_f8f6f4(Bt[n].f8, At[m].f8, acc[ai][bj][m][n], 0, 0, 0, 0x7f7f7f7f, 0, 0x7f7f7f7f); \
        else { _Pragma("unroll") for (int k = 0; k < 2; ++k) acc[ai][bj][m][n] = mma16(Bt[n].h[k], At[m].h[k], acc[ai][bj][m][n]); } \
        if constexpr (DT == 2) asm volatile("" : "+v"(acc[ai][bj][m][n]));   } \
        __builtin_amdgcn_s_setprio(0); } while (0)
#define PG8_WAIT_V(n) asm volatile("s_waitcnt vmcnt(" #n ")" ::: "memory")
#define PG8_WAIT_L(n) asm volatile("s_waitcnt lgkmcnt(" #n ")" ::: "memory")
#define PG8_BAR __builtin_amdgcn_s_barrier()
#define PG8_SCHED __builtin_amdgcn_sched_barrier(0)
    Unit cur, nxt; int ui = 0;
    if (!S.next(0, cur)) { H(-1); return; }
    acc_t acc[2][2][4][2];
#pragma unroll
    for (int a = 0; a < 2; ++a)
#pragma unroll
        for (int b = 0; b < 2; ++b)
#pragma unroll
            for (int m = 0; m < 4; ++m)
#pragma unroll
                for (int n = 0; n < 2; ++n) acc[a][b][m][n] = (acc_t){0, 0, 0, 0};
    struct Frag { bf16x8 h[2]; i32x8 f8; };
    Frag At[4], B0[2], B1[2];
    const char* cA = S.aptr(cur); const char* cB = S.bptr(cur);
    if (GATHER) S.gather(cur, gA, tid);
    PG8_STAGE(PG8_SB(0, 0), cB, voffB); PG8_STAGE(PG8_SB(0, 1), cB + hstep, voffB); PG8_STAGE_A(PG8_SA(0, 0), 0, cA); PG8_STAGE_A(PG8_SA(0, 1), 1, cA);
    if (wr == 1) PG8_BAR;
    PG8_WAIT_V(2); PG8_BAR;
    PG8_STAGE(PG8_SB(1, 0), cB + kstep, voffB); PG8_STAGE_A(PG8_SA(1, 0), 0, cA + kstep); PG8_STAGE(PG8_SB(1, 1), cB + hstep + kstep, voffB);
    PG8_WAIT_V(6); PG8_BAR;
    for (;;) {
        const bool has_next = S.next(ui + 1, nxt);
        const char* nA = has_next ? S.aptr(nxt) : cA; const char* nB = has_next ? S.bptr(nxt) : cB;
        {
            if constexpr (GATHER) { if (has_next && wid == 0) __builtin_amdgcn_global_load_lds((const unsigned*)(S.list_src(nxt) + 4 * lane), (LAS unsigned*)(aux + ((ui + 1) & 1) * 1024), 16, 0, 0); }
            if constexpr (Epi::PREFETCH) E.prefetch(cur, aux + 2048 + (ui & 1) * 3072, wid, lane);
        }
        for (int t = 0; t < nt; t += 2) {
            const bool last = (t == nt - 2);
            const char* a1 = cA + (size_t)(t + 1) * kstep;
            const char* a2 = last ? nA : cA + (size_t)(t + 2) * kstep; const char* b2 = last ? nB : cB + (size_t)(t + 2) * kstep;
            const char* a3 = a2 + kstep; const char* b3 = b2 + kstep;
            PG8_LDB(B0, 0, 0); PG8_LDB(B1, 0, 1); PG8_SCHED; PG8_LDA(At, 0, 0); PG8_STAGE_A(PG8_SA(1, 1), 1, a1);
            if (GATHER) { if (last && has_next) S.gather_lds(nxt, gA, tid, aux + ((ui + 1) & 1) * 1024); }
            PG8_WAIT_V(8); PG8_WAIT_L(0); PG8_BAR; PG8_MMA(0, 0, At, B0); PG8_MMA(0, 1, At, B1); PG8_BAR; PG8_SCHED;
            PG8_LDA(At, 0, 1); PG8_STAGE(PG8_SB(0, 0), b2, voffB); PG8_STAGE(PG8_SB(0, 1), b2 + hstep, voffB); PG8_STAGE_A(PG8_SA(0, 0), 0, a2);
            PG8_WAIT_V(8); PG8_WAIT_L(0); PG8_BAR; PG8_MMA(1, 0, At, B0); PG8_MMA(1, 1, At, B1); PG8_BAR; PG8_SCHED;
            PG8_LDB(B0, 1, 0); PG8_LDB(B1, 1, 1); PG8_SCHED; PG8_LDA(At, 1, 0); PG8_STAGE_A(PG8_SA(0, 1), 1, a2);
            PG8_WAIT_V(8); PG8_WAIT_L(0); PG8_BAR; PG8_MMA(0, 0, At, B0); PG8_MMA(0, 1, At, B1); PG8_BAR; PG8_SCHED;
            PG8_LDA(At, 1, 1); PG8_STAGE(PG8_SB(1, 0), b3, voffB); PG8_STAGE(PG8_SB(1, 1), b3 + hstep, voffB); PG8_STAGE_A(PG8_SA(1, 0), 0, a3);
            PG8_WAIT_V(8); PG8_WAIT_L(0); PG8_BAR; PG8_MMA(1, 0, At, B0); PG8_MMA(1, 1, At, B1); PG8_BAR; PG8_SCHED;
        }
        if (wr == 0) PG8_BAR;
        E(acc, cur, wr, wc, fr, fq, aux + 2048 + (ui & 1) * 3072);
        H(ui);
        if (!has_next) break;
#pragma unroll
        for (int a = 0; a < 2; ++a)
#pragma unroll
            for (int b = 0; b < 2; ++b)
#pragma unroll
                for (int m = 0; m < 4; ++m)
#pragma unroll
                    for (int n = 0; n < 2; ++n) acc[a][b][m][n] = (acc_t){0, 0, 0, 0};
        cur = nxt; cA = nA; cB = nB; ++ui;
        if (wr == 1) PG8_BAR;
    }
    PG8_WAIT_V(0);
    PG8_BAR;
    H(-1);
#undef PG8_SA
#undef PG8_SB
#undef PG8_STAGE
#undef PG8_STAGE_A
#undef PG8_LDA
#undef PG8_LDB
#undef PG8_MMA
#undef PG8_WAIT_V
#undef PG8_WAIT_L
#undef PG8_BAR
#undef PG8_SCHED
}
}

template <int MODE  >
__device__ __forceinline__ void tconv_item(const float* W, int N, bf16_t* Bt, int kb, int nb, int lane) {
    const int k0 = kb * 64, n = nb * 64 + lane;
    float v[64];
#pragma unroll
    for (int i = 0; i < 64; ++i) v[i] = W[(size_t)(k0 + i) * N + n];
    int row = n;
    if (MODE == 1) { const int j = n >> 1, par = n & 1; row = ((j >> 4) << 5) + (par << 4) + (j & 15); }
    u32x4* dst = (u32x4*)(Bt + (size_t)row * D + k0);
#pragma unroll
    for (int c = 0; c < 8; ++c) { u32x4 o; o.x = cvt_pk_bf16(v[8 * c], v[8 * c + 1]); o.y = cvt_pk_bf16(v[8 * c + 2], v[8 * c + 3]); o.z = cvt_pk_bf16(v[8 * c + 4], v[8 * c + 5]); o.w = cvt_pk_bf16(v[8 * c + 6], v[8 * c + 7]); dst[c] = o; }
}
template <bool PERMGL, bool FP8>
__device__ __forceinline__ void q8_cols_item(const float* W, int N, int n0, unsigned char* Bq, float* sc_out, LAS float* AM, int par, int wave, int lane) {
    const int n = n0 + lane;
    const float* Wp = W + (size_t)(128 * wave) * N + n;
    float v[128]; float am = 0.f;
#pragma unroll
    for (int i = 0; i < 128; ++i) v[i] = Wp[(size_t)i * N];
    __builtin_amdgcn_sched_barrier(0);
#pragma unroll
    for (int i = 0; i < 128; ++i) am = fmaxf(am, fabsf(v[i]));
    AM[(par * 8 + wave) * 64 + lane] = am;
    __syncthreads();
#pragma unroll
    for (int w = 0; w < 8; ++w) am = fmaxf(am, AM[(par * 8 + w) * 64 + lane]);
    const float sc = am > 0.f ? am * (FP8 ? (1.0f / 256.0f) : (1.0f / 127.0f)) : 1.0f, inv = 1.0f / sc;
    int row = n;
    if (PERMGL) { const int j = n >> 1, pr = n & 1, o = j & 127; row = ((j >> 7) << 8) + (((o >> 2) & 1) << 7) + ((o >> 5) << 5) + (pr << 4) + (((o >> 3) & 3) << 2) + (o & 3); }
    if (!PERMGL) { const int o = n & 255; row = ((n >> 8) << 8) + (((o >> 3) & 1) << 7) + ((o >> 6) << 5) + (((o >> 4) & 3) << 3) + (o & 7); }
    u32x4* dst = (u32x4*)(Bq + (size_t)row * 1024 + 128 * wave);
#pragma unroll
    for (int c = 0; c < 8; ++c) { u32x4 o;
        if (FP8) { o.x = f8x4(v[16 * c], v[16 * c + 1], v[16 * c + 2], v[16 * c + 3], inv); o.y = f8x4(v[16 * c + 4], v[16 * c + 5], v[16 * c + 6], v[16 * c + 7], inv);
                   o.z = f8x4(v[16 * c + 8], v[16 * c + 9], v[16 * c + 10], v[16 * c + 11], inv); o.w = f8x4(v[16 * c + 12], v[16 * c + 13], v[16 * c + 14], v[16 * c + 15], inv); }
        else { o.x = q8x4(v[16 * c], v[16 * c + 1], v[16 * c + 2], v[16 * c + 3], inv); o.y = q8x4(v[16 * c + 4], v[16 * c + 5], v[16 * c + 6], v[16 * c + 7], inv);
               o.z = q8x4(v[16 * c + 8], v[16 * c + 9], v[16 * c + 10], v[16 * c + 11], inv); o.w = q8x4(v[16 * c + 12], v[16 * c + 13], v[16 * c + 14], v[16 * c + 15], inv); }
        dst[c] = o; }
    if (wave == 0) sc_out[PERMGL ? row : n] = FP8 ? sc * 16.0f : sc;
}
__device__ __forceinline__ void fold_item(const float* pool_w, const float* pool_scale, const float* w_out, bf16_t* BtOut, int item, int lane) {
    const int kq = item & 7, nb = (item >> 3) & 15, g = (item >> 7) & 3, i = item >> 9;
    const int n = nb * 64 + lane, kk0 = kq * 16;
    const float* pw = pool_w + ((size_t)(i * 4 + g) * 128 + kk0) * 128;
    const float* sc = pool_scale + i * 512 + g * 128;
    const float* wo = w_out + ((size_t)i * 1024 + g * 128) * D + n;
    float a0[16], a1[16];
    { const float s0 = sc[lane], s1 = sc[64 + lane];
#pragma unroll
      for (int k = 0; k < 16; ++k) { a0[k] = pw[k * 128 + lane] * s0; a1[k] = pw[k * 128 + 64 + lane] * s1; } }
    float acc[16];
#pragma unroll
    for (int k = 0; k < 16; ++k) acc[k] = 0.f;
#pragma unroll 8
    for (int c = 0; c < 64; ++c) { const float w0 = wo[(size_t)c * D], w1 = wo[(size_t)(c + 64) * D];
#pragma unroll
        for (int k = 0; k < 16; ++k) { acc[k] += __int_as_float(__builtin_amdgcn_readlane(__float_as_int(a0[k]), c)) * w0; acc[k] += __int_as_float(__builtin_amdgcn_readlane(__float_as_int(a1[k]), c)) * w1; } }
    u32x4* dst = (u32x4*)(BtOut + ((size_t)i * 1024 + n) * D + g * 128 + kk0);
    u32x4 o0, o1;
    o0.x = cvt_pk_bf16(acc[0], acc[1]); o0.y = cvt_pk_bf16(acc[2], acc[3]); o0.z = cvt_pk_bf16(acc[4], acc[5]); o0.w = cvt_pk_bf16(acc[6], acc[7]);
    o1.x = cvt_pk_bf16(acc[8], acc[9]); o1.y = cvt_pk_bf16(acc[10], acc[11]); o1.z = cvt_pk_bf16(acc[12], acc[13]); o1.w = cvt_pk_bf16(acc[14], acc[15]);
    dst[0] = o0; dst[1] = o1;
}

__device__ __forceinline__ bf16x8 ld16(const char* base, unsigned off) { return *(const bf16x8*)(base + off); }
struct TileD { int kb, d; float flim; bool valid; };
__device__ __forceinline__ void attn_load(const char* kp_base, const char* vp_base, const TileD& t_, bf16x8 (&kf)[2][2], bf16x8 (&vr)[4], int lane) {
    const int c = lane & 15, g = lane >> 4;
    TileD t = t_; asm volatile("" : "+s"(t.kb));
    if (!t.valid) {
#pragma unroll
        for (int j = 0; j < 4; ++j) { kf[j >> 1][j & 1] = (bf16x8){0, 0, 0, 0, 0, 0, 0, 0}; vr[j] = (bf16x8){0, 0, 0, 0, 0, 0, 0, 0}; }
        return; }
#pragma unroll
    for (int kt2 = 0; kt2 < 2; ++kt2) { const int kp = t.kb + t.d * (16 * kt2 + c);
        const unsigned off = (unsigned)kp * (unsigned)(ODD_IN * 2) + 16u * g;
        kf[kt2][0] = ld16(kp_base, off); kf[kt2][1] = ld16(kp_base, off + 64u); }
#pragma unroll
    for (int j = 0; j < 4; ++j) { const int ch = lane + 64 * j, row = ch >> 3, cc = ch & 7; const int kp = t.kb + t.d * row;
        vr[j] = ld16(vp_base, (unsigned)kp * (unsigned)(ODD_IN * 2) + 16u * cc); }
}
__device__ __forceinline__ void attn_vwrite(const bf16x8 (&vr)[4], LAS unsigned char* vbuf, int lane) {
#pragma unroll
    for (int j = 0; j < 4; ++j) { const int ch = lane + 64 * j; *(LAS bf16x8*)(vbuf + (ch >> 3) * 160 + (ch & 7) * 16) = vr[j]; }
}
typedef short s16x4 __attribute__((ext_vector_type(4)));
__device__ __forceinline__ void attn_vfrag(const LAS unsigned char* vbuf, bf16x8 (&vf)[4], int lane) {
    const LAS unsigned char* p = vbuf + (4 * (lane >> 4) + ((lane >> 2) & 3)) * 160 + 8 * (lane & 3);
#pragma unroll
    for (int mt = 0; mt < 4; ++mt) { const s16x4 a = __builtin_amdgcn_ds_read_tr16_b64_v4i16((LAS s16x4*)(p + 32 * mt)), b = __builtin_amdgcn_ds_read_tr16_b64_v4i16((LAS s16x4*)(p + 2560 + 32 * mt));
        vf[mt] = __builtin_shufflevector(a, b, 0, 1, 2, 3, 4, 5, 6, 7); }
}
template <int NH, class InitF>
__device__ __forceinline__ void attn_core(const bf16x8 (&kf)[2][2], const LAS unsigned char* vbuf, const InitF& initf  ,
                                          const bf16x8 (&bq)[NH][2], float (&m)[NH], float (&l)[NH], f32x4 (&O)[NH][4], int lane) {
    bf16x8 vf[4];
    attn_vfrag(vbuf, vf, lane);
#pragma unroll
    for (int hq = 0; hq < NH; ++hq) {
        f32x4 s0 = initf(hq, 0), s1 = initf(hq, 1);
        s0 = __builtin_amdgcn_mfma_f32_16x16x32_bf16(kf[0][0], bq[hq][0], s0, 0, 0, 0); s0 = __builtin_amdgcn_mfma_f32_16x16x32_bf16(kf[0][1], bq[hq][1], s0, 0, 0, 0);
        s1 = __builtin_amdgcn_mfma_f32_16x16x32_bf16(kf[1][0], bq[hq][0], s1, 0, 0, 0); s1 = __builtin_amdgcn_mfma_f32_16x16x32_bf16(kf[1][1], bq[hq][1], s1, 0, 0, 0);
        float mx = fmaxf(fmaxf(fmaxf(s0[0], s0[1]), fmaxf(s0[2], s0[3])), fmaxf(fmaxf(s1[0], s1[1]), fmaxf(s1[2], s1[3])));
        mx = fmaxf(mx, xor_sw<16>(mx)); mx = max_x32(mx);
        const float mn = fmaxf(m[hq], mx), corr = __builtin_amdgcn_exp2f(m[hq] - mn); m[hq] = mn;
        float p[8];
#pragma unroll
        for (int i = 0; i < 8; ++i) p[i] = __builtin_amdgcn_exp2f((i < 4 ? s0[i & 3] : s1[i & 3]) - mn);
        const float ps = ((p[0] + p[1]) + (p[2] + p[3])) + ((p[4] + p[5]) + (p[6] + p[7]));
        l[hq] = l[hq] * corr + ps;
        u32x4 pw; pw.x = cvt_pk_bf16(p[0], p[1]); pw.y = cvt_pk_bf16(p[2], p[3]); pw.z = cvt_pk_bf16(p[4], p[5]); pw.w = cvt_pk_bf16(p[6], p[7]);
        const bf16x8 pb = __builtin_bit_cast(bf16x8, pw);
        if (__builtin_amdgcn_ballot_w64(corr != 1.0f) != 0ull) {
#pragma unroll
            for (int mt = 0; mt < 4; ++mt) O[hq][mt] *= corr; }
#pragma unroll
        for (int mt = 0; mt < 4; ++mt) O[hq][mt] = __builtin_amdgcn_mfma_f32_16x16x32_bf16(vf[mt], pb, O[hq][mt], 0, 0, 0);
    }
}
template <int NH, class InitF>
__device__ __forceinline__ void attn_core64(const LAS unsigned char* kbuf  , const LAS unsigned char* vbuf  , const InitF& initf  ,
                                            const bf16x8 (&bq)[NH][2], float (&m)[NH], float (&l)[NH], f32x4 (&O)[NH][4], int lane) {
    const int c = lane & 15, g = lane >> 4;
    bf16x8 pb[NH][2]; float corr[NH];
#pragma unroll
    for (int hq = 0; hq < NH; ++hq) {
        f32x4 sa[4];
#pragma unroll
        for (int t = 0; t < 4; ++t) sa[t] = initf(hq, t);
#pragma unroll
        for (int t = 0; t < 4; ++t) { const bf16x8 k0 = *(const LAS bf16x8*)(kbuf + (16 * t + c) * 144 + 16 * g), k1 = *(const LAS bf16x8*)(kbuf + (16 * t + c) * 144 + 16 * g + 64);
            sa[t] = __builtin_amdgcn_mfma_f32_16x16x32_bf16(k0, bq[hq][0], sa[t], 0, 0, 0); sa[t] = __builtin_amdgcn_mfma_f32_16x16x32_bf16(k1, bq[hq][1], sa[t], 0, 0, 0); }
        float mx = -3.0e38f;
#pragma unroll
        for (int t = 0; t < 4; ++t) mx = fmaxf(mx, fmaxf(fmaxf(sa[t][0], sa[t][1]), fmaxf(sa[t][2], sa[t][3])));
        mx = fmaxf(mx, xor_sw<16>(mx)); mx = max_x32(mx);
        const float mn = fmaxf(m[hq], mx); corr[hq] = __builtin_amdgcn_exp2f(m[hq] - mn); m[hq] = mn;
        float p[16];
#pragma unroll
        for (int i = 0; i < 16; ++i) p[i] = __builtin_amdgcn_exp2f(sa[i >> 2][i & 3] - mn);
        const float ps = (((p[0] + p[1]) + (p[2] + p[3])) + ((p[4] + p[5]) + (p[6] + p[7]))) + (((p[8] + p[9]) + (p[10] + p[11])) + ((p[12] + p[13]) + (p[14] + p[15])));
        l[hq] = l[hq] * corr[hq] + ps;
        u32x4 pw0, pw1;
        pw0.x = cvt_pk_bf16(p[0], p[1]); pw0.y = cvt_pk_bf16(p[2], p[3]); pw0.z = cvt_pk_bf16(p[4], p[5]); pw0.w = cvt_pk_bf16(p[6], p[7]);
        pw1.x = cvt_pk_bf16(p[8], p[9]); pw1.y = cvt_pk_bf16(p[10], p[11]); pw1.z = cvt_pk_bf16(p[12], p[13]); pw1.w = cvt_pk_bf16(p[14], p[15]);
        pb[hq][0] = __builtin_bit_cast(bf16x8, pw0); pb[hq][1] = __builtin_bit_cast(bf16x8, pw1);
    }
#pragma unroll
    for (int hq = 0; hq < NH; ++hq) {
        if (__builtin_amdgcn_ballot_w64(corr[hq] != 1.0f) != 0ull) {
#pragma unroll
            for (int mt = 0; mt < 4; ++mt) O[hq][mt] *= corr[hq]; } }
#pragma unroll
    for (int sb = 0; sb < 2; ++sb) { bf16x8 vf[4];
        attn_vfrag(vbuf + 5120 * sb, vf, lane);
#pragma unroll
        for (int hq = 0; hq < NH; ++hq)
#pragma unroll
            for (int mt = 0; mt < 4; ++mt) O[hq][mt] = __builtin_amdgcn_mfma_f32_16x16x32_bf16(vf[mt], pb[hq][sb], O[hq][mt], 0, 0, 0);
    }
}
template <int NH, int P, class Desc, class BiasF>
__device__ __forceinline__ void attn_unit(const char* kp_base, const char* vp_base, const Desc& dsc, int ntile, const BiasF& biasf, const bf16x8 (&bq)[NH][2],
                                          float (&m)[NH], float (&l)[NH], f32x4 (&O)[NH][4], LAS unsigned char* vl  , int lane) {
    constexpr int U = (P % 2 == 0) ? P : 2 * P;
    bf16x8 kf[P][2][2], vr[P][4];
#pragma unroll
    for (int s = 0; s < P; ++s) attn_load(kp_base, vp_base, dsc(s), kf[s], vr[s], lane);
    attn_vwrite(vr[0], vl, lane);
#pragma unroll 1
    for (int t0 = 0; t0 < ntile; t0 += U) {
#pragma unroll
        for (int u = 0; u < U; ++u) {
            const int t = t0 + u;
            attn_vwrite(vr[(u + 1) % P], vl + ((u + 1) & 1) * 5120, lane);
            const TileD td = dsc(t);
            if (td.valid) { const LAS unsigned char* bp[NH];
#pragma unroll
                for (int hq = 0; hq < NH; ++hq) bp[hq] = biasf(td, hq);
                auto initf = [&](int hq, int hh) { return *(const LAS f32x4*)(bp[hq] + 64 * hh); };
                attn_core<NH>(kf[u % P], vl + (u & 1) * 5120, initf, bq, m, l, O, lane); }
            attn_load(kp_base, vp_base, dsc(t + P), kf[u % P], vr[u % P], lane);
        }
    }
}
constexpr int SH_K = 0, SH_V = 9216, SH_BUF = 19456;
__device__ __forceinline__ bf16x8 attn_sh_load(const char* kp_base, const char* vp_base, int kb, int tid, int r) {
    kb = kb < 0 ? 0 : (kb > SEQ - 64 ? SEQ - 64 : kb);
    const int row = 32 * r + ((tid & 255) >> 3), cc = tid & 7; const int kp = kb + row;
    return ld16((tid >> 8) ? vp_base : kp_base, (unsigned)kp * (unsigned)(ODD_IN * 2) + 16u * cc);
}
__device__ __forceinline__ void attn_sh_write(bf16x8 v, LAS unsigned char* buf, int tid, int r) {
    const int row = 32 * r + ((tid & 255) >> 3), cc = tid & 7;
    *(LAS bf16x8*)(buf + ((tid >> 8) ? SH_V + row * 160 : SH_K + row * 144) + cc * 16) = v;
}
template <int NH, int NQ, bool TABLE>
__device__ __forceinline__ void attn_stream(const char* kp_base, const char* vp_base, int kb0, int ntile  , float flim, const float (&fqp)[NQ], const LAS unsigned char* const (&tab)[NQ], const float (&slope2)[NH], const bf16x8 (&bq)[NH][2],
                                            float (&m)[NH], float (&l)[NH], f32x4 (&O)[NH][4], LAS unsigned char* sh, int tid, int lane, int jlo, int jhi  ) {
    const int g = lane >> 4;
    int iq[NQ];
#pragma unroll
    for (int q = 0; q < NQ; ++q) iq[q] = 4 * g - (int)fqp[q];
    bf16x8 ra[2];
#pragma unroll
    for (int r = 0; r < 2; ++r) { ra[r] = attn_sh_load(kp_base, vp_base, kb0, tid, r); }
#pragma unroll
    for (int r = 0; r < 2; ++r) attn_sh_write(ra[r], sh, tid, r);
#pragma unroll
    for (int r = 0; r < 2; ++r) ra[r] = attn_sh_load(kp_base, vp_base, kb0 + 64, tid, r);
    __syncthreads();
    for (int j = 0; j < ntile; ++j) {
        const int kb = kb0 + 64 * j; LAS unsigned char* buf = sh + (j & 1) * SH_BUF;
        if (j >= jlo && j <= jhi && !(kb + 63 < 0 || kb >= SEQ)) {
            if constexpr (TABLE) {
                const LAS unsigned char* bp[NQ];
#pragma unroll
                for (int q = 0; q < NQ; ++q) bp[q] = tab[q] + 4 * kb;
                auto initf = [&](int hq, int t) { return *(const LAS f32x4*)(bp[hq] + 64 * t); };
                attn_core64<NH>(buf + SH_K, buf + SH_V, initf, bq, m, l, O, lane);
            } else {
                const float fb = (float)(kb + iq[0]);
                if (__builtin_amdgcn_ballot_w64(!(fabsf(fb) <= flim && fabsf(fb + 51.f) <= flim)) == 0ull) {
                    auto initf = [&](int hq, int t) { f32x4 v;
#pragma unroll
                        for (int r = 0; r < 4; ++r) v[r] = -slope2[hq] * fabsf(fb + (float)(16 * t + r));
                        return v; };
                    attn_core64<NH>(buf + SH_K, buf + SH_V, initf, bq, m, l, O, lane);
                } else {
                    auto initf = [&](int hq, int t) { f32x4 v;
#pragma unroll
                        for (int r = 0; r < 4; ++r) { const float ad = fabsf(fb + (float)(16 * t + r)); v[r] = __builtin_fmaf(-slope2[hq], ad, (ad <= flim) ? 0.f : -3.0e38f); }
                        return v; };
                    attn_core64<NH>(buf + SH_K, buf + SH_V, initf, bq, m, l, O, lane);
                }
            }
        }
#pragma unroll
        for (int r = 0; r < 2; ++r) attn_sh_write(ra[r], sh + ((j + 1) & 1) * SH_BUF, tid, r);
#pragma unroll
        for (int r = 0; r < 2; ++r) ra[r] = attn_sh_load(kp_base, vp_base, kb0 + 64 * (j + 2), tid, r);
        __syncthreads();
    }
}
template <int NH>
__device__ __forceinline__ void attn_store(bf16_t* orow  , const int (&ocol)[NH], const float (&l)[NH], const float (&extra)[NH], const f32x4 (&O)[NH][4], int lane) {
    const int g = lane >> 4;
#pragma unroll
    for (int hq = 0; hq < NH; ++hq) { float lt = l[hq]; lt += xor_sw<16>(lt); lt = sum_x32(lt); lt += extra[hq];
        const float inv = 1.0f / lt;
#pragma unroll
        for (int mt = 0; mt < 4; ++mt) { u32x2 w;
            w.x = cvt_pk_bf16(O[hq][mt][0] * inv, O[hq][mt][1] * inv); w.y = cvt_pk_bf16(O[hq][mt][2] * inv, O[hq][mt][3] * inv);
            *(u32x2*)(orow + ocol[hq] + 16 * mt + 4 * g) = w; } }
}
__device__ __forceinline__ bf16x8 q_prescale(bf16x8 q) {
    const u32x4 w = __builtin_bit_cast(u32x4, q); float f[8]; unpack8(w, f);
#pragma unroll
    for (int i = 0; i < 8; ++i) f[i] *= 0.18033688011112042f;
    return __builtin_bit_cast(bf16x8, pack8(f));
}
__device__ __forceinline__ void ln_row16(float (&v)[16], const float* lng, const float* lnb, int lane, float (&o)[16]) {
    const float s = ((v[0] + v[1]) + (v[2] + v[3])) + ((v[4] + v[5]) + (v[6] + v[7])) + (((v[8] + v[9]) + (v[10] + v[11])) + ((v[12] + v[13]) + (v[14] + v[15])));
    const float mean = wave_sum(s) * (1.0f / D);
#pragma unroll
    for (int i = 0; i < 16; ++i) v[i] -= mean;
    const float s2 = ((v[0] * v[0] + v[1] * v[1]) + (v[2] * v[2] + v[3] * v[3])) + ((v[4] * v[4] + v[5] * v[5]) + (v[6] * v[6] + v[7] * v[7]))
                   + (((v[8] * v[8] + v[9] * v[9]) + (v[10] * v[10] + v[11] * v[11])) + ((v[12] * v[12] + v[13] * v[13]) + (v[14] * v[14] + v[15] * v[15])));
    const float rstd = 1.0f / sqrtf(wave_sum(s2) * (1.0f / D) + LN_EPS);
#pragma unroll
    for (int hf = 0; hf < 2; ++hf) { const int col = 512 * hf + 8 * lane;
        const f32x4 g0 = *(const f32x4*)(lng + col), g1 = *(const f32x4*)(lng + col + 4), b0 = *(const f32x4*)(lnb + col), b1 = *(const f32x4*)(lnb + col + 4);
#pragma unroll
        for (int i = 0; i < 4; ++i) { o[8 * hf + i] = v[8 * hf + i] * rstd * g0[i] + b0[i]; o[8 * hf + 4 + i] = v[8 * hf + 4 + i] * rstd * g1[i] + b1[i]; } }
}
__device__ __forceinline__ float q8_row16(const float (&o)[16], unsigned char* qrow, int lane) {
    float am = 0.f;
#pragma unroll
    for (int i = 0; i < 16; ++i) am = fmaxf(am, fabsf(o[i]));
    am = wave_max(am);
    const float qs = am > 0.f ? am * (1.0f / 127.0f) : 1.0f, qinv = 1.0f / qs;
#pragma unroll
    for (int hf = 0; hf < 2; ++hf) { u32x2 q; q.x = q8x4(o[8 * hf], o[8 * hf + 1], o[8 * hf + 2], o[8 * hf + 3], qinv); q.y = q8x4(o[8 * hf + 4], o[8 * hf + 5], o[8 * hf + 6], o[8 * hf + 7], qinv);
        *(u32x2*)(qrow + 512 * hf + 8 * lane) = q; }
    return qs;
}
__device__ __forceinline__ void store_bf16_row16(const float (&o)[16], bf16_t* row, int lane) {
#pragma unroll
    for (int hf = 0; hf < 2; ++hf) { const float (&oh)[8] = *(const float (*)[8])(o + 8 * hf); *(u32x4*)(row + 512 * hf + 8 * lane) = pack8(oh); }
}
struct Args { const float* in[17]; float* out; unsigned char* ws; int ph_lo, ph_hi; };

__global__ void __launch_bounds__(NWAVES * 64, 2) mk_fwd(Args args) {
    extern __shared__ __attribute__((aligned(16))) unsigned char lds_raw[];
    LAS unsigned char* lds = (LAS unsigned char*)lds_raw;
    const int G = gridDim.x, bx = blockIdx.x;
    const int wave_s = __builtin_amdgcn_readfirstlane(threadIdx.x >> 6);
    const int vcu = (G % 8 == 0) ? (bx % 8) * (G / 8) + bx / 8 : bx;
    const int NGW = G * NWAVES;
#define PHASE_IDS() int lane = lane_id(); asm volatile("" : "+v"(lane)); const int wave = wave_s, tid = wave_s * 64 + lane, gw = vcu * NWAVES + wave; (void)tid; (void)gw
    unsigned char* ws = args.ws;
    unsigned* ctl = (unsigned*)(ws + WS_CTL);
    bf16_t* XB = (bf16_t*)(ws + WS_XB); bf16_t* HB = (bf16_t*)(ws + WS_H); bf16_t* CAT = (bf16_t*)(ws + WS_CAT); bf16_t* YB = (bf16_t*)(ws + WS_Y);
    bf16_t* ACT = (bf16_t*)(ws + WS_ACT); bf16_t* YS = (bf16_t*)(ws + WS_YS); int* LIST = (int*)(ws + WS_LIST); i32x4* INFO = (i32x4*)(ws + WS_INFO);
    volatile LAS unsigned* MISC = (volatile LAS unsigned*)(lds + MISC_OFF);
    LAS int* CN = (LAS int*)(lds + TAB_OFF); LAS int* TB = (LAS int*)(lds + TAB_OFF + 128);
    if (threadIdx.x < 16) MISC[threadIdx.x] = 0u;
    __syncthreads();
#if MK_N_LAUNCHES == 1
    XcdBarrier bar = xcd_barrier_post(ctl + CW_BAR, MISC + 8);
#define GRID_BAR() xcd_barrier(bar, wave_s)
#else
#define GRID_BAR() do {} while (0)
#endif
#if MK_N_LAUNCHES == 1
#define IN(k) true
#define SEAM(k) GRID_BAR()
#else
    const int lo = args.ph_lo, hi = args.ph_hi;
#define IN(k) (lo <= (k) && (k) < hi)
#define SEAM(k) do {} while (0)
#endif

    for (int rep = 0; rep < NREP(7); ++rep) if (IN(0)) {
        PHASE_IDS();
        {
            LAS float* AM = (LAS float*)lds;
            int par = 0;
            for (int it = bx; it < 64 + 72; it += G, par ^= 1) {
                if (it < 64) { const int mi = it >> 5, nb = it & 31;
                    q8_cols_item<false, false>(args.in[1] + (size_t)mi * D * EVEN_IN, EVEN_IN, nb * 64, ws + WS_EVIN + (size_t)mi * EVEN_IN * 1024, (float*)(ws + WS_SBIN) + mi * EVEN_IN, AM, par, wave, lane); }
                else { const int r = it - 64, mi = r / 36, nb = r % 36;
                    q8_cols_item<false, false>(args.in[6] + (size_t)mi * D * ODD_IN, ODD_IN, nb * 64, ws + WS_ODIN + (size_t)mi * ODD_IN * 1024, (float*)(ws + WS_SBIN) + 16384 + mi * ODD_IN, AM, par, wave, lane); }
            }
            __syncthreads();
        }
        const float* ev_w_out = args.in[5]; const float* od_w_out = args.in[8];
        constexpr int I6 = 1024, I2 = 2 * 16 * 16, I3 = 2 * 8 * 16;
        constexpr int NITEMS = I6 + I2 + I3;
        for (int it = gw; it < NITEMS; it += NGW) {
            int r = __builtin_amdgcn_readfirstlane(it);
            if (r < I6) { fold_item(args.in[2], args.in[3], ev_w_out, (bf16_t*)(ws + WS_EVOUT), r, lane); continue; } r -= I6;
            if (r < I2) { const int mi = r / 256, q = r % 256; tconv_item<0>(od_w_out + (size_t)mi * D * D, D, (bf16_t*)(ws + WS_ODOUT) + (size_t)mi * D * D, q / 16, q % 16, lane); continue; } r -= I2;
            { const int mi = r / 128, q = r % 128; tconv_item<0>(ev_w_out + (size_t)mi * D * D, D, (bf16_t*)(ws + WS_EVOUT) + (size_t)mi * D * D, 8 + q / 16, q % 16, lane); }
        }
        const float* x = args.in[0];
        for (int t = gw; t < T; t += NGW) {
            float o[16];
#pragma unroll
            for (int hf = 0; hf < 2; ++hf) { const f32x4 a = *(const f32x4*)(x + (size_t)t * D + 512 * hf + 8 * lane), b = *(const f32x4*)(x + (size_t)t * D + 512 * hf + 8 * lane + 4);
#pragma unroll
                for (int i = 0; i < 4; ++i) { o[8 * hf + i] = a[i]; o[8 * hf + 4 + i] = b[i]; } }
            store_bf16_row16(o, XB + (size_t)t * D, lane);
            const float qs = q8_row16(o, ws + WS_XQ + (size_t)t * D, lane);
            if (lane == 0) ((float*)(ws + WS_SX))[t] = qs;
        }
    }
    SEAM(0);

    for (int layer = 0; layer < DEPTH; ++layer) {
        const int li = layer >> 1, odd = layer & 1, P = 1 + layer * PH_PER_LAYER;
        for (int rep = 0; rep < NREP(0); ++rep) if (IN(P + 0)) {
            pg8::DenseSched<true> S;
            if (odd) S.init(ws + WS_XQ, ws + WS_ODIN + (size_t)li * ODD_IN * 1024, T, ODD_IN, G, bx);
            else S.init(ws + WS_XQ, ws + WS_EVIN + (size_t)li * EVEN_IN * 1024, T, EVEN_IN, G, bx);
            pg8::EpiBf16<0> E{HB, odd ? ODD_IN : EVEN_IN, nullptr, nullptr, 0.f, (const float*)(ws + WS_SX), (const float*)(ws + WS_SBIN) + (odd ? 16384 + li * ODD_IN : li * EVEN_IN)};
            bool cv_fired = false;
            auto cv_hook = [&](int ui) {
                if (layer != 0 || cv_fired || (ui >= 0 && ui != ((bx >> 3) & 3))) return;
                cv_fired = true;
                LAS float* CAM = (LAS float*)(lds + RING_BYTES + 576 + 8192); const int lane_h = lane_id(); int par = 0;
#pragma unroll 1
                for (int r = bx; r < 1536; r += G, par ^= 1) {
                    if (r < 1024) { const int mi = r >> 5, nb = ((r & 31) + 8 * ((r >> 6) & 3)) & 31;
                        q8_cols_item<true, false>(args.in[11] + (size_t)mi * D * 2048, 2048, nb * 64, ws + WS_WGU + (size_t)mi * 2048 * 1024, (float*)(ws + WS_SB) + (size_t)mi * 2048, CAM, par, wave_s, lane_h); }
                    else { const int r2 = r - 1024, mi = r2 >> 4, nb = ((r2 & 15) + 8 * ((r2 >> 6) & 1)) & 15;
                        q8_cols_item<false, true>(args.in[13] + (size_t)mi * D * D, D, nb * 64, ws + WS_WDN + (size_t)mi * D * 1024, (float*)(ws + WS_SBD) + (size_t)mi * D, CAM, par, wave_s, lane_h); } }
                __syncthreads();
            };
            pg8::gemm_phase<1>(lds, S, E, wave_s, lds + RING_BYTES + 576, cv_hook);
        }
        SEAM(P + 0);
        for (int rep = 0; rep < NREP(1); ++rep) if (IN(P + 1)) {
            PHASE_IDS();
            if (!odd) {
                const float* conv_w = args.in[4] + (size_t)li * 3 * 512;
                for (int task = gw; task < 2048; task += NGW) {
                    const int run = task >> 1, kind = task & 1, b = run >> 6, t0 = (run & 63) * 32;
                    const bf16_t* hb = HB + (size_t)b * SEQ * EVEN_IN; bf16_t* cb = CAT + (size_t)b * SEQ * D;
                    if (kind == 0) {
                        const int ch0 = 8 * lane, half = 1 << (lane >> 4);
                        const bf16_t* base = hb + ch0;
                        float sum[8];
#pragma unroll
                        for (int i = 0; i < 8; ++i) sum[i] = 0.f;
                        {   u32x4 r0[16];
#pragma unroll
                            for (int j = 0; j < 16; ++j) { int p = t0 + j - 8; p = p < 0 ? 0 : (p > SEQ - 1 ? SEQ - 1 : p); r0[j] = *(const u32x4*)(base + (size_t)p * EVEN_IN); }
                            __builtin_amdgcn_sched_barrier(0);
#pragma unroll
                            for (int j = 0; j < 16; ++j) { const int dp = j - 8, p = t0 + dp; const float fl = (dp >= -half && dp < half && p >= 0 && p < SEQ) ? 1.f : 0.f;
                                float f[8]; unpack8(r0[j], f);
#pragma unroll
                                for (int i = 0; i < 8; ++i) sum[i] += fl * f[i]; } }
                        for (int tc = t0; tc < t0 + 32; tc += 8) {
                            u32x4 ru[8], ra[8], rb[8];
#pragma unroll
                            for (int j = 0; j < 8; ++j) { const int t = tc + j, pa = (t + half < SEQ) ? t + half : SEQ - 1, pb = (t - half >= 0) ? t - half : 0;
                                ru[j] = *(const u32x4*)(base + (size_t)t * EVEN_IN); ra[j] = *(const u32x4*)(base + (size_t)pa * EVEN_IN); rb[j] = *(const u32x4*)(base + (size_t)pb * EVEN_IN); }
                            __builtin_amdgcn_sched_barrier(0);
#pragma unroll
                            for (int j = 0; j < 8; ++j) { const int t = tc + j;
                                const int wlo = (t - half) > 0 ? (t - half) : 0, whi = (t + half) < SEQ ? (t + half) : SEQ;
                                const float rc = 1.0f / (float)(whi - wlo), fa = (t + half < SEQ) ? 1.f : 0.f, fb = (t - half >= 0) ? 1.f : 0.f;
                                float u[8], o[8], f[8]; unpack8(ru[j], u);
#pragma unroll
                                for (int i = 0; i < 8; ++i) o[i] = sum[i] * rc - u[i];
                                *(u32x4*)(cb + (size_t)t * D + ch0) = pack8(o);
                                unpack8(ra[j], f);
#pragma unroll
                                for (int i = 0; i < 8; ++i) sum[i] += fa * f[i];
                                unpack8(rb[j], f);
#pragma unroll
                                for (int i = 0; i < 8; ++i) sum[i] -= fb * f[i]; }
                        }
                    } else {
                        const int ch0 = 8 * lane;
                        float w0[8], w1[8], w2[8];
                        { const f32x4 a0 = *(const f32x4*)(conv_w + ch0), a1 = *(const f32x4*)(conv_w + ch0 + 4), b0 = *(const f32x4*)(conv_w + 512 + ch0), b1 = *(const f32x4*)(conv_w + 512 + ch0 + 4),
                                      c0 = *(const f32x4*)(conv_w + 1024 + ch0), c1 = *(const f32x4*)(conv_w + 1024 + ch0 + 4);
#pragma unroll
                          for (int i = 0; i < 4; ++i) { w0[i] = a0[i]; w0[4 + i] = a1[i]; w1[i] = b0[i]; w1[4 + i] = b1[i]; w2[i] = c0[i]; w2[4 + i] = c1[i]; } }
                        const bf16_t* pb = hb + 512 + ch0; const bf16_t* pc = hb + 1024 + ch0; const bf16_t* pv = hb + 1536 + ch0;
                        float up[8], uc[8], un[8];
#pragma unroll
                        for (int i = 0; i < 8; ++i) up[i] = 0.f;
                        if (t0 > 0) { float c[8], v[8]; unpack8(*(const u32x4*)(pc + (size_t)(t0 - 1) * EVEN_IN), c); unpack8(*(const u32x4*)(pv + (size_t)(t0 - 1) * EVEN_IN), v);
#pragma unroll
                            for (int i = 0; i < 8; ++i) up[i] = c[i] * v[i]; }
                        { float c[8], v[8]; unpack8(*(const u32x4*)(pc + (size_t)t0 * EVEN_IN), c); unpack8(*(const u32x4*)(pv + (size_t)t0 * EVEN_IN), v);
#pragma unroll
                            for (int i = 0; i < 8; ++i) uc[i] = c[i] * v[i]; }
                        for (int tc = t0; tc < t0 + 32; tc += 8) {
                            u32x4 rc_[8], rv_[8], rg_[8];
#pragma unroll
                            for (int j = 0; j < 8; ++j) { const int t = tc + j, pn = (t + 1 < SEQ) ? t + 1 : SEQ - 1;
                                rc_[j] = *(const u32x4*)(pc + (size_t)pn * EVEN_IN); rv_[j] = *(const u32x4*)(pv + (size_t)pn * EVEN_IN); rg_[j] = *(const u32x4*)(pb + (size_t)t * EVEN_IN); }
                            __builtin_amdgcn_sched_barrier(0);
#pragma unroll
                            for (int j = 0; j < 8; ++j) { const int t = tc + j; const float fn = (t + 1 < SEQ) ? 1.f : 0.f;
                                float c[8], v[8], bg[8], o[8]; unpack8(rc_[j], c); unpack8(rv_[j], v); unpack8(rg_[j], bg);
#pragma unroll
                                for (int i = 0; i < 8; ++i) { un[i] = fn * (c[i] * v[i]); o[i] = bg[i] * (up[i] * w0[i] + uc[i] * w1[i] + un[i] * w2[i]); up[i] = uc[i]; uc[i] = un[i]; }
                                *(u32x4*)(cb + (size_t)t * D + 512 + ch0) = pack8(o); }
                        }
                    }
                }
            } else {
                const float* sinkp = args.in[7] + li * 8;
                LAS unsigned char* vl = lds + wave * 10240;
                LAS unsigned char* sh = lds + 81920;
                const int c = lane & 15, g = lane >> 4;
                constexpr float LOG2E = 1.4426950408889634f;
                const int cv_first = layer, cv_n = (layer == 1) ? 2 * 1536 : 1536;
                int cv_it = bx, cv_par = 0, cv_done = 0;
                const int cv_mine = (cv_n - bx + G - 1) / G;
                const int n_bu = (2048 - bx + G - 1) / G;
                LAS float* CAM = (LAS float*)(lds + 120832);
                LAS float* TAB16 = (LAS float*)(lds + 124928);
                LAS float* TAB1 = (LAS float*)(lds + 131136);
                LAS float* TAB4 = (LAS float*)(lds + 141504);
                {   int hh = (bx >> 3) & 7; asm volatile("" : "+s"(hh));
                    const float sl2 = exp2f(-(float)(hh + 1)) * LOG2E;
                    for (int i = tid; i < 4 * 648; i += NWAVES * 64) { const int sft = i / 648, k = i - sft * 648; const float ad = fabsf((float)(k - sft - 320)); TAB1[i] = ad <= 64.f ? -sl2 * ad : -3.0e38f; }
                    for (int i = tid; i < 4 * 260; i += NWAVES * 64) { const int sft = i / 260, k = i - sft * 260; const float a1 = fabsf((float)(k - sft - 128));
                        TAB4[i] = 4.f * a1 <= 256.f ? -sl2 * 4.f * a1 : -3.0e38f; TAB16[i] = 16.f * a1 <= 1024.f ? -sl2 * 16.f * a1 : -3.0e38f; }
                    __syncthreads(); }
                int bu_idx = 0;
                for (int bu = bx; bu < 2048; bu += G, ++bu_idx) {
                    {   const int target = (bu_idx >= ((bx >> 3) % n_bu)) ? cv_mine : 0;
                        for (; cv_done < target; ++cv_done, cv_it += G, cv_par ^= 1) {
                            const int lyr = cv_first + cv_it / 1536, r = cv_it % 1536;
                            if (r < 1024) { const int mi = lyr * 32 + (r >> 5), nb = ((r & 31) + 8 * ((r >> 6) & 3)) & 31;
                                q8_cols_item<true, false>(args.in[11] + (size_t)mi * D * 2048, 2048, nb * 64, ws + WS_WGU + (size_t)mi * 2048 * 1024, (float*)(ws + WS_SB) + (size_t)mi * 2048, CAM, cv_par, wave, lane); }
                            else { const int r2 = r - 1024, mi = lyr * 32 + (r2 >> 4), nb = ((r2 & 15) + 8 * ((r2 >> 6) & 1)) & 15;
                                q8_cols_item<false, true>(args.in[13] + (size_t)mi * D * D, D, nb * 64, ws + WS_WDN + (size_t)mi * D * 1024, (float*)(ws + WS_SBD) + (size_t)mi * D, CAM, cv_par, wave, lane); }
                        }
                    }
                    int c_u = lane & 15, g_u = lane >> 4; asm volatile("" : "+v"(c_u), "+v"(g_u));
                    const int c = c_u, g = g_u;
                    if (bu < 1024) {
                        const int b = bu >> 6, h = (bu >> 3) & 7, ib = bu & 7;
                        const bf16_t* hb = HB + (size_t)b * SEQ * ODD_IN;
                        const char* kpb = (const char*)(hb + 512 + h * 64); const char* vpb = (const char*)(hb + 1024 + h * 64);
                        const float slope2[1] = {exp2f(-(float)(h + 1)) * LOG2E};
                        bf16x8 bq[2][2]; float m[2], l[2], fq2[2]; f32x4 O[2][4];
                        auto per_wave_part = [&](auto RR) { constexpr int rr = decltype(RR)::value;
                            const int rho = wave + 8 * rr, q0 = rho + 256 * ib, qp = q0 + 16 * c;
                            bf16x8 bq1[1][2];
                            { const bf16_t* qr = hb + (size_t)qp * ODD_IN + h * 64 + 8 * g; bq1[0][0] = q_prescale(*(const bf16x8*)qr); bq1[0][1] = q_prescale(*(const bf16x8*)(qr + 32)); }
                            float m1[1] = {-1e30f}, l1[1] = {0.f}; f32x4 O1[1][4];
#pragma unroll
                            for (int mt = 0; mt < 4; ++mt) O1[0][mt] = (f32x4){0.f, 0.f, 0.f, 0.f};
                            auto dsc = [&](int tl) { TileD t; t.kb = rho + 512 * tl; t.d = 16; t.flim = 1024.f;
                                t.valid = (tl < 4) && (512 * tl - 256 * ib - 240 <= 1024) && (256 * ib - 512 * tl - 496 <= 1024); return t; };
                            const LAS unsigned char* t16 = (const LAS unsigned char*)TAB16 + 1040 * (c & 3) + 4 * (128 + (c & 3) - 16 * ib - c + 4 * g);
                            auto bias16 = [&](const TileD& t, int) { return t16 + ((t.kb - rho) >> 2); };
                            attn_unit<1, 2>(kpb, vpb, dsc, 4, bias16, bq1, m1, l1, O1, vl, lane);
                            bq[rr][0] = bq1[0][0]; bq[rr][1] = bq1[0][1]; m[rr] = m1[0]; l[rr] = l1[0]; fq2[rr] = (float)qp;
#pragma unroll
                            for (int mt = 0; mt < 4; ++mt) O[rr][mt] = O1[0][mt];
                        };
                        per_wave_part(std::integral_constant<int, 0>{}); per_wave_part(std::integral_constant<int, 1>{});
                        const float slope22[2] = {slope2[0], slope2[0]};
                        {
                            const int kb4 = 256 * (ib - 1) + (wave & 3);
                            auto dsc4 = [&](int tl) { TileD t; t.kb = kb4 + 128 * tl; t.d = 4; t.flim = 256.f; t.valid = (tl < 6) && !(t.kb < 0 || t.kb >= SEQ); return t; };
                            const LAS unsigned char* t4[2];
#pragma unroll
                            for (int q = 0; q < 2; ++q) { const int s4 = ((wave >> 2) + 2 * q) & 3; t4[q] = (const LAS unsigned char*)TAB4 + 1040 * s4 + 4 * (128 + s4 - 64 - (wave >> 2) - 2 * q + 4 * g - 4 * c) - kb4; }
                            auto bias4 = [&](const TileD& t, int q) { return (q == 0 ? t4[0] : t4[1]) + t.kb; };
                            attn_unit<2, 2>(kpb, vpb, dsc4, 6, bias4, bq, m, l, O, vl, lane);
                        }
                        bf16x8 qraw[2][2];
#pragma unroll
                        for (int sl = 0; sl < 2; ++sl) { const bf16_t* qr = hb + (size_t)(256 * ib + 32 * wave + 16 * sl + c) * ODD_IN + h * 64 + 8 * g; qraw[sl][0] = *(const bf16x8*)qr; qraw[sl][1] = *(const bf16x8*)(qr + 32); }
                        __syncthreads();
                        {   LAS float* PARK = (LAS float*)lds;
#pragma unroll
                            for (int q = 0; q < 2; ++q) { float lt = l[q]; lt += xor_sw<16>(lt); lt = sum_x32(lt);
                                const int pp = wave + 8 * q + 16 * c;
#pragma unroll
                                for (int mt = 0; mt < 4; ++mt) *(LAS f32x4*)(PARK + pp * 68 + 4 * ((4 * mt + g) ^ c)) = O[q][mt];
                                if (g == 0) { PARK[pp * 68 + 64] = m[q]; PARK[pp * 68 + 65] = lt; } }
                            const LAS unsigned char* t1[2];
#pragma unroll
                            for (int sl = 0; sl < 2; ++sl) { const int qp = 256 * ib + 32 * wave + 16 * sl + c;
                                bq[sl][0] = q_prescale(qraw[sl][0]); bq[sl][1] = q_prescale(qraw[sl][1]);
                                m[sl] = -1e30f; l[sl] = 0.f; fq2[sl] = (float)qp;
#pragma unroll
                                for (int mt = 0; mt < 4; ++mt) O[sl][mt] = (f32x4){0.f, 0.f, 0.f, 0.f};
                                t1[sl] = (const LAS unsigned char*)TAB1 + 2592 * (c & 3) + 4 * (320 + (c & 3) + 4 * g - qp); }
                            attn_stream<2, 2, true>(kpb, vpb, 256 * ib - 64, 6, 64.f, fq2, t1, slope22, bq, m, l, O, sh, tid, lane, wave >> 1, (wave >> 1) + 2);
#pragma unroll
                            for (int sl = 0; sl < 2; ++sl) { const int pp = 32 * wave + 16 * sl + c, sw = (2 * wave + sl) & 15;
                                float lt = l[sl]; lt += xor_sw<16>(lt); lt = sum_x32(lt);
                                const float mc = PARK[pp * 68 + 64], lc = PARK[pp * 68 + 65];
                                const float mn = fmaxf(m[sl], mc), fa = __builtin_amdgcn_exp2f(m[sl] - mn), fb = __builtin_amdgcn_exp2f(mc - mn);
                                const float inv = 1.0f / (lt * fa + lc * fb);
                                bf16_t* orow = CAT + (size_t)(b * SEQ + 256 * ib + pp) * D + h * 64;
#pragma unroll
                                for (int mt = 0; mt < 4; ++mt) { const f32x4 oc = *(const LAS f32x4*)(PARK + pp * 68 + 4 * ((4 * mt + g) ^ sw)); const f32x4 v = (O[sl][mt] * fa + oc * fb) * inv;
                                    u32x2 w; w.x = cvt_pk_bf16(v[0], v[1]); w.y = cvt_pk_bf16(v[2], v[3]); *(u32x2*)(orow + 16 * mt + 4 * g) = w; } }
                        }
                        __syncthreads();
                    } else {
                        const int ud = bu - 1024, b = ud >> 6, kvh = (ud >> 5) & 1, qb = ud & 31;
                        const bf16_t* hb = HB + (size_t)b * SEQ * ODD_IN;
                        const int hp = wave & 1, q0 = 64 * qb + 16 * (wave >> 1), qp = q0 + c;
                        bf16x8 bq[2][2]; float m[2], l[2], slope2[2]; f32x4 O[2][4];
#pragma unroll
                        for (int j = 0; j < 2; ++j) { const int hq = 4 * kvh + 2 * hp + j; const bf16_t* qr = hb + (size_t)qp * ODD_IN + 1536 + hq * 64 + 8 * g;
                            bq[j][0] = q_prescale(*(const bf16x8*)qr); bq[j][1] = q_prescale(*(const bf16x8*)(qr + 32)); m[j] = -1e30f; l[j] = 0.f; slope2[j] = exp2f(-(float)(hq + 1)) * LOG2E;
#pragma unroll
                            for (int mt = 0; mt < 4; ++mt) O[j][mt] = (f32x4){0.f, 0.f, 0.f, 0.f}; }
                        const char* kpb = (const char*)(hb + 2048 + kvh * 64); const char* vpb = (const char*)(hb + 2176 + kvh * 64);
                        { const float fq1[1] = {(float)qp}; const LAS unsigned char* const notab[1] = {nullptr}; attn_stream<2, 1, false>(kpb, vpb, 64 * qb - 128, 5, 128.f, fq1, notab, slope2, bq, m, l, O, sh, tid, lane, 0, 4); }
                        int ocol[2]; float extra[2];
#pragma unroll
                        for (int j = 0; j < 2; ++j) { const int hq = 4 * kvh + 2 * hp + j; ocol[j] = 512 + hq * 64; extra[j] = __builtin_amdgcn_exp2f(sinkp[hq] * LOG2E - m[j]); }
                        attn_store<2>(CAT + (size_t)(b * SEQ + qp) * D, ocol, l, extra, O, lane);
                    }
                }
                __syncthreads();
            }
        }
        SEAM(P + 1);
        for (int rep = 0; rep < NREP(2); ++rep) if (IN(P + 2)) {
            pg8::DenseSched<false> S; S.init(CAT, odd ? (bf16_t*)(ws + WS_ODOUT) + (size_t)li * D * D : (bf16_t*)(ws + WS_EVOUT) + (size_t)li * D * D, T, D, G, bx);
            pg8::EpiBf16<1> E{YB, D, XB, nullptr, ALPHA, nullptr, nullptr};
            pg8::gemm_phase<0>(lds, S, E, wave_s, lds + RING_BYTES + 576);
        }
        SEAM(P + 2);
        if (IN(P + 3)) {
            PHASE_IDS();
            constexpr int XS = 1028;
            LAS float* XL = (LAS float*)lds;
            LAS float* PART = (LAS float*)(lds + 65792);
            LAS float* LOG = (LAS float*)(lds + 82176);
            LAS int* LCNT = (LAS int*)(lds + 84224);
            LAS int* GBASE = (LAS int*)(lds + 84352);
            LAS i32x4* REC = (LAS i32x4*)(lds + 84480);
            LAS float* TSC = (LAS float*)(lds + 122880);
            LAS float* TOP = (LAS float*)(lds + 124928);
            const float* lng = args.in[15] + (size_t)(layer * 2 + 0) * D; const float* lnb = args.in[16] + (size_t)(layer * 2 + 0) * D;
            const float* rw = args.in[9] + (size_t)layer * D * NEXP; const float* rb = args.in[10] + layer * NEXP;
            if (tid < 32) LCNT[tid] = 0;
            __syncthreads();
            const int tk = lane & 15, kq = lane >> 4;
            auto split8 = [](const float (&f)[8], bf16x8& hi, bf16x8& lo) { const u32x4 h = pack8(f); float fh[8], fl[8]; unpack8(h, fh);
#pragma unroll
                for (int i = 0; i < 8; ++i) fl[i] = f[i] - fh[i];
                hi = __builtin_bit_cast(bf16x8, h); lo = __builtin_bit_cast(bf16x8, pack8(fl)); };
            bf16x8 rwh[4][2], rwl[4][2];
#pragma unroll
            for (int ks = 0; ks < 4; ++ks)
#pragma unroll
                for (int tile = 0; tile < 2; ++tile) { float f[8];
#pragma unroll
                    for (int j = 0; j < 8; ++j) f[j] = rw[(size_t)(128 * wave + 32 * ks + 8 * kq + j) * NEXP + 16 * tile + tk];
                    split8(f, rwh[ks][tile], rwl[ks][tile]); }
            int nbatch = 0;
            for (int rep = 0; rep < NREP(3); ++rep) {
            const bool dummy = rep + 1 < NREP(3);
            bf16_t* XBo = dummy ? CAT : XB; unsigned char* XQo = dummy ? (unsigned char*)HB : ws + WS_XQ;
            if (rep > 0) { __syncthreads(); if (tid < 32) LCNT[tid] = 0; __syncthreads(); }
            nbatch = 0;
            u32x4 yp[2][2];
            {   const int b0 = bx < T / 16 ? bx : 0;
#pragma unroll
                for (int ii = 0; ii < 2; ++ii) { const size_t t = (size_t)b0 * 16 + wave * 2 + ii; yp[ii][0] = *(const u32x4*)(YB + t * D + 8 * lane); yp[ii][1] = *(const u32x4*)(YB + t * D + 512 + 8 * lane); } }
            for (int bi = bx; bi < T / 16; bi += G, ++nbatch) {
                u32x4 yc[2][2];
#pragma unroll
                for (int ii = 0; ii < 2; ++ii) { yc[ii][0] = yp[ii][0]; yc[ii][1] = yp[ii][1]; }
                {   const int bn = (bi + G < T / 16) ? bi + G : bi;
#pragma unroll
                    for (int ii = 0; ii < 2; ++ii) { const size_t t = (size_t)bn * 16 + wave * 2 + ii; yp[ii][0] = *(const u32x4*)(YB + t * D + 8 * lane); yp[ii][1] = *(const u32x4*)(YB + t * D + 512 + 8 * lane); } }
#pragma unroll
                for (int ii = 0; ii < 2; ++ii) {
                    const int tl = wave * 2 + ii, t = bi * 16 + tl;
                    float v[16], o[16];
#pragma unroll
                    for (int hf = 0; hf < 2; ++hf) { float f[8]; unpack8(yc[ii][hf], f);
#pragma unroll
                        for (int i = 0; i < 8; ++i) v[8 * hf + i] = f[i]; }
                    ln_row16(v, lng, lnb, lane, o);
#pragma unroll
                    for (int hf = 0; hf < 2; ++hf) { const int col = 512 * hf + 8 * lane;
                        *(LAS f32x4*)(XL + tl * XS + col) = (f32x4){o[8 * hf], o[8 * hf + 1], o[8 * hf + 2], o[8 * hf + 3]}; *(LAS f32x4*)(XL + tl * XS + col + 4) = (f32x4){o[8 * hf + 4], o[8 * hf + 5], o[8 * hf + 6], o[8 * hf + 7]}; }
                    const float qs = q8_row16(o, XQo + (size_t)t * D, lane);
                    if (lane == 0) TSC[nbatch * 16 + tl] = qs;
                }
                __syncthreads();
                {
                    f32x4 a0 = (f32x4){0.f, 0.f, 0.f, 0.f}, a1 = (f32x4){0.f, 0.f, 0.f, 0.f};
#pragma unroll
                    for (int ks = 0; ks < 4; ++ks) { const LAS float* xp = XL + tk * XS + 128 * wave + 32 * ks + 8 * kq; const f32x4 p = *(const LAS f32x4*)xp, q = *(const LAS f32x4*)(xp + 4);
                        const float f[8] = {p[0], p[1], p[2], p[3], q[0], q[1], q[2], q[3]}; bf16x8 xh, xl; split8(f, xh, xl);
                        a0 = __builtin_amdgcn_mfma_f32_16x16x32_bf16(xh, rwh[ks][0], a0, 0, 0, 0); a1 = __builtin_amdgcn_mfma_f32_16x16x32_bf16(xh, rwh[ks][1], a1, 0, 0, 0);
                        a0 = __builtin_amdgcn_mfma_f32_16x16x32_bf16(xh, rwl[ks][0], a0, 0, 0, 0); a1 = __builtin_amdgcn_mfma_f32_16x16x32_bf16(xh, rwl[ks][1], a1, 0, 0, 0);
                        a0 = __builtin_amdgcn_mfma_f32_16x16x32_bf16(xl, rwh[ks][0], a0, 0, 0, 0); a1 = __builtin_amdgcn_mfma_f32_16x16x32_bf16(xl, rwh[ks][1], a1, 0, 0, 0); }
#pragma unroll
                    for (int r = 0; r < 4; ++r) { PART[(wave * 16 + 4 * kq + r) * 32 + tk] = a0[r]; PART[(wave * 16 + 4 * kq + r) * 32 + 16 + tk] = a1[r]; }
                }
                __syncthreads();
                {   const int tq = tid >> 5, e = tid & 31; float s = rb[e];
#pragma unroll
                    for (int w = 0; w < 8; ++w) s += PART[(w * 16 + tq) * 32 + e];
                    const unsigned ub = __float_as_uint(s), key = (((ub >> 31) ? ~ub : (ub | 0x80000000u)) & ~31u) | (unsigned)(31 - e);
                    ((LAS unsigned*)LOG)[tq * 32 + e] = key;
                    asm volatile("s_waitcnt lgkmcnt(0)" ::: "memory");
                    int rank = 0;
#pragma unroll
                    for (int q = 0; q < 8; ++q) { const u32x4 t4 = *(const LAS u32x4*)((LAS unsigned*)LOG + tq * 32 + 4 * q);
#pragma unroll
                        for (int r = 0; r < 4; ++r) rank += (t4[r] > key) ? 1 : 0; }
                    if (rank < 4) TOP[tq * 4 + rank] = s;
                    asm volatile("s_waitcnt lgkmcnt(0)" ::: "memory");
                    if (rank < 4) {
                        const f32x4 tv = *(const LAS f32x4*)(TOP + tq * 4);
                        const float es = 1.0f + __expf(tv[1] - tv[0]) + __expf(tv[2] - tv[0]) + __expf(tv[3] - tv[0]);
                        const float wgt = __expf(s - tv[0]) * (1.0f / es);
                        const int lp = atomicAdd((int*)(LCNT + e), 1);
                        REC[(nbatch * 16 + tq) * 4 + rank] = (i32x4){e, lp, __float_as_int(wgt), bi * 16 + tq}; }
                }
            }
            }
            __syncthreads();
            if (tid < 32) { const int cc = LCNT[tid]; GBASE[tid] = cc ? (int)atomicAdd(ctl + CW_CNT + layer * 64 + tid, (unsigned)cc) : 0; }
            __syncthreads();
            for (int a = tid; a < nbatch * 64; a += NWAVES * 64) { const i32x4 r = REC[a]; const int pos = GBASE[r.x] + r.y;
                LIST[(size_t)r.x * T + pos] = r.w; ((float*)(ws + WS_SXS))[(size_t)r.x * T + pos] = TSC[a >> 2]; INFO[(size_t)r.w * 4 + (a & 3)] = (i32x4){r.x, pos, r.z, 0}; }
            __syncthreads();
        }
        SEAM(P + 3);
        if (IN(P + 4) || IN(P + 5) || IN(P + 6)) {
            PHASE_IDS();
            if (tid < 32) CN[tid] = (int)__hip_atomic_load(ctl + CW_CNT + layer * 64 + tid, __ATOMIC_RELAXED, __HIP_MEMORY_SCOPE_AGENT);
            __syncthreads();
            if (tid == 0) { int s = 0; for (int e = 0; e < 32; ++e) { TB[e] = s; s += (CN[e] + 255) >> 8; } TB[32] = s; }
            __syncthreads();
        }
        for (int rep = 0; rep < NREP(4); ++rep) if (IN(P + 4)) {
            pg8::MoeSched<true, true> S; S.A = (const char*)(ws + WS_XQ); S.Bt = (const char*)(ws + WS_WGU) + (size_t)layer * NEXP * 2048 * D; S.list = LIST; S.tb = TB; S.cn = CN; S.NN = 8; S.total = TB[32] * 8; S.G = G; S.vcu = vcu;
            pg8::EpiSwiGLU E{ACT, args.in[12] + (size_t)layer * NEXP * 2048, (const float*)(ws + WS_SB) + (size_t)layer * NEXP * 2048, (const float*)(ws + WS_SXS)};
            pg8::gemm_phase<1>(lds, S, E, wave_s, lds + RING_BYTES + 576);
        }
        SEAM(P + 4);
        for (int rep = 0; rep < NREP(5); ++rep) if (IN(P + 5)) {
            pg8::MoeSched<false, true> S; S.A = (const char*)ACT; S.Bt = (const char*)(ws + WS_WDN) + (size_t)layer * NEXP * D * 1024; S.list = LIST; S.tb = TB; S.cn = CN; S.NN = 4; S.total = TB[32] * 4; S.G = G; S.vcu = vcu;
            pg8::EpiBf16<3> E{YS, D, nullptr, args.in[14] + (size_t)layer * NEXP * D, 0.f, nullptr, (const float*)(ws + WS_SBD) + (size_t)layer * NEXP * D};
            pg8::gemm_phase<2>(lds, S, E, wave_s, lds + RING_BYTES + 576);
        }
        SEAM(P + 5);
        if (IN(P + 6)) {
            PHASE_IDS();
            const float* lng = args.in[15] + (size_t)(layer * 2 + 1) * D; const float* lnb = args.in[16] + (size_t)(layer * 2 + 1) * D;
            const float* lng1 = args.in[15] + (size_t)(layer * 2 + 0) * D; const float* lnb1 = args.in[16] + (size_t)(layer * 2 + 0) * D;
            for (int rep = 0; rep < NREP(6); ++rep) {
            const bool dummy = rep + 1 < NREP(6);
            bf16_t* XBo = dummy ? YB : XB; unsigned char* XQo = dummy ? (unsigned char*)CAT : ws + WS_XQ; float* SXo = dummy ? (float*)ACT : (float*)(ws + WS_SX); float* OUTo = dummy ? (float*)HB : args.out;
            auto tok_of = [&](int t0, int j) { return (j == 0 || t0 + NGW >= T) ? t0 : t0 + NGW; };
            auto load_raw = [&](int t0) { return INFO[(size_t)tok_of(t0, (lane >> 2) & 1) * 4 + (lane & 3)]; };
            auto unpack_raw = [&](const i32x4& raw, int (&e)[2][4], int (&p)[2][4], float (&gq)[2][4]) {
#pragma unroll
                for (int j = 0; j < 2; ++j)
#pragma unroll
                    for (int k = 0; k < 4; ++k) { e[j][k] = __builtin_amdgcn_readlane(raw.x, 4 * j + k); p[j][k] = __builtin_amdgcn_readlane(raw.y, 4 * j + k);
                        gq[j][k] = __int_as_float(__builtin_amdgcn_readlane(raw.z, 4 * j + k)) * (1.0f / 16.0f); } };
            auto load_rows = [&](int t0, const int (&e)[2][4], const int (&p)[2][4], u32x4 (&xr)[2][2], u32x2 (&yr)[2][4][2]) {
#pragma unroll
                for (int j = 0; j < 2; ++j) { const int t = tok_of(t0, j);
                    xr[j][0] = *(const u32x4*)(YB + (size_t)t * D + 8 * lane); xr[j][1] = *(const u32x4*)(YB + (size_t)t * D + 512 + 8 * lane);
#pragma unroll
                    for (int k = 0; k < 4; ++k) { const unsigned char* yp = (const unsigned char*)YS + ((size_t)TB[e[j][k]] * 256 + p[j][k]) * D;
                        yr[j][k][0] = *(const u32x2*)(yp + 8 * lane); yr[j][k][1] = *(const u32x2*)(yp + 512 + 8 * lane); } } };
            u32x4 xr[2][2], xrn[2][2]; u32x2 yr[2][4][2], yrn[2][4][2]; float gt[2][4];
            i32x4 raw = load_raw(gw);
            { int e0[2][4], p0[2][4]; unpack_raw(raw, e0, p0, gt); load_rows(gw, e0, p0, xr, yr); }
            raw = load_raw((gw + 2 * NGW < T) ? gw + 2 * NGW : gw);
            for (int t0 = gw; t0 < T; t0 += 2 * NGW) {
                int tt[2]; tt[0] = t0; tt[1] = tok_of(t0, 1);
                const int t1 = (t0 + 2 * NGW < T) ? t0 + 2 * NGW : t0, t2 = (t1 + 2 * NGW < T) ? t1 + 2 * NGW : t1;
                int en[2][4], pn[2][4]; float gn[2][4];
                unpack_raw(raw, en, pn, gn);
                load_rows(t1, en, pn, xrn, yrn);
                raw = load_raw(t2);
                __builtin_amdgcn_sched_barrier(0);
                float o[2][16];
#pragma unroll
                for (int j = 0; j < 2; ++j) {
                    float v[16], x1[16];
#pragma unroll
                    for (int hf = 0; hf < 2; ++hf) { float f[8]; unpack8(xr[j][hf], f);
#pragma unroll
                        for (int i = 0; i < 8; ++i) v[8 * hf + i] = f[i]; }
                    ln_row16(v, lng1, lnb1, lane, x1);
#pragma unroll
                    for (int hf = 0; hf < 2; ++hf) { float f[8];
#pragma unroll
                        for (int i = 0; i < 8; ++i) v[8 * hf + i] = ALPHA * x1[8 * hf + i];
#pragma unroll
                        for (int k = 0; k < 4; ++k) { unpack8_f8(yr[j][k][hf], f);
#pragma unroll
                            for (int i = 0; i < 8; ++i) v[8 * hf + i] += gt[j][k] * f[i]; } }
                    ln_row16(v, lng, lnb, lane, o[j]);
                }
#pragma unroll
                for (int j = 0; j < 2; ++j) {
                    const int t = tt[j];
                    if (layer == DEPTH - 1) {
#pragma unroll
                        for (int hf = 0; hf < 2; ++hf) { float* op = OUTo + (size_t)t * D + 512 * hf + 8 * lane;
                            *(f32x4*)op = (f32x4){o[j][8 * hf], o[j][8 * hf + 1], o[j][8 * hf + 2], o[j][8 * hf + 3]}; *(f32x4*)(op + 4) = (f32x4){o[j][8 * hf + 4], o[j][8 * hf + 5], o[j][8 * hf + 6], o[j][8 * hf + 7]}; }
                    } else {
                        store_bf16_row16(o[j], XBo + (size_t)t * D, lane);
                        const float qs = q8_row16(o[j], XQo + (size_t)t * D, lane);
                        if (lane == 0) SXo[t] = qs;
                    }
                }
#pragma unroll
                for (int j = 0; j < 2; ++j) { xr[j][0] = xrn[j][0]; xr[j][1] = xrn[j][1];
#pragma unroll
                    for (int k = 0; k < 4; ++k) { yr[j][k][0] = yrn[j][k][0]; yr[j][k][1] = yrn[j][k][1]; gt[j][k] = gn[j][k]; } }
            }
            }
        }
        if (layer + 1 < DEPTH) SEAM(P + 6);
    }
#undef IN
#undef SEAM
}

extern "C" void kernel_launch(void* const* d_in, const int* in_sizes, int n_in, void* d_out, int out_size, void* d_ws, size_t ws_size, hipStream_t stream) {
    static int grid = 0;
    if (grid == 0) {
        if (n_in != 17 || out_size != T * D || ws_size < WS_END) { fprintf(stderr, "kernel_launch: unexpected shapes (n_in %d, out %d, ws %zu)\n", n_in, out_size, ws_size); grid = -1; return; }
        int dev = 0, cus = 0;
        if (hipGetDevice(&dev) != hipSuccess || hipDeviceGetAttribute(&cus, hipDeviceAttributeMultiprocessorCount, dev) != hipSuccess) { grid = -1; return; }
        if (hipFuncSetAttribute((const void*)mk_fwd, hipFuncAttributeMaxDynamicSharedMemorySize, LDS_BYTES) != hipSuccess) { fprintf(stderr, "kernel_launch: hipFuncSetAttribute failed\n"); grid = -1; return; }
        int per_cu = 0;
        if (hipOccupancyMaxActiveBlocksPerMultiprocessor(&per_cu, (const void*)mk_fwd, NWAVES * 64, LDS_BYTES) != hipSuccess || per_cu < 1) fprintf(stderr, "kernel_launch: occupancy query reports %d\n", per_cu);
        (void)hipGetLastError();
        grid = cus;
        if (grid < 64) { fprintf(stderr, "kernel_launch: needs >= 64 CUs\n"); grid = -1; return; }
    }
    if (grid < 0) return;
    (void)hipMemsetAsync((char*)d_ws + WS_CTL, 0, CTL_ZERO_BYTES, stream);
    Args a{};
    for (int i = 0; i < 17; ++i) a.in[i] = (const float*)d_in[i];
    a.out = (float*)d_out; a.ws = (unsigned char*)d_ws;
#if MK_N_LAUNCHES == 1
    a.ph_lo = 0; a.ph_hi = N_PHASES;
    hipLaunchKernelGGL(mk_fwd, dim3(grid), dim3(NWAVES * 64), LDS_BYTES, stream, a);
#else
    for (int p = 0; p < N_PHASES; ++p) { a.ph_lo = p; a.ph_hi = p + 1; hipLaunchKernelGGL(mk_fwd, dim3(grid), dim3(NWAVES * 64), LDS_BYTES, stream, a); }
#endif
}
```

```cpp
#include <hip/hip_runtime.h>
#include <cstdio>
#include <cstdint>
#include <type_traits>

#ifndef MK_N_LAUNCHES
#define MK_N_LAUNCHES 1
#endif

#ifndef PROBE_REP_PH
#define PROBE_REP_PH (-1)
#endif
#define NREP(k) ((PROBE_REP_PH == (k)) ? 2 : 1)
#define LAS __attribute__((address_space(3)))
typedef unsigned short bf16_t;
typedef short bf16x8 __attribute__((ext_vector_type(8)));
typedef float f32x4 __attribute__((ext_vector_type(4)));
typedef unsigned u32x4 __attribute__((ext_vector_type(4)));
typedef unsigned u32x2 __attribute__((ext_vector_type(2)));
typedef int i32x4 __attribute__((ext_vector_type(4)));
typedef int i32x8 __attribute__((ext_vector_type(8)));

constexpr int BATCH = 16, SEQ = 2048, D = 1024, T = BATCH * SEQ, DEPTH = 4;
constexpr int EVEN_IN = 2048, ODD_IN = 2304, NEXP = 32, TOPK = 4;
constexpr float ALPHA = 1.6817928305074292f;
constexpr float LN_EPS = 1e-5f;
constexpr int NWAVES = 8;
constexpr int PH_PER_LAYER = 7, N_PHASES = 1 + DEPTH * PH_PER_LAYER;

constexpr size_t MiB = 1u << 20;
constexpr size_t WS_CTL = 0, CTL_ZERO_BYTES = 64 * 1024;
constexpr size_t WS_EVIN = 2 * MiB;
constexpr size_t WS_EVOUT = 10 * MiB;
constexpr size_t WS_ODIN = 14 * MiB;
constexpr size_t WS_ODOUT = 24 * MiB;
constexpr size_t WS_WGU = 32 * MiB;
constexpr size_t WS_SB = 288 * MiB;
constexpr size_t WS_SBIN = 289 * MiB;
constexpr size_t WS_SX = 289 * MiB + 512 * 1024;
constexpr size_t WS_XQ = 290 * MiB;
constexpr size_t WS_SBD = 332 * MiB;
constexpr size_t WS_SXS = 326 * MiB;
constexpr size_t WS_WDN = 544 * MiB;
constexpr size_t WS_XB = 800 * MiB;
constexpr size_t WS_H = 864 * MiB;
constexpr size_t WS_CAT = 1008 * MiB;
constexpr size_t WS_Y = 1072 * MiB;
constexpr size_t WS_ACT = 1136 * MiB;
constexpr size_t WS_YS = 1408 * MiB;
constexpr size_t WS_LIST = 1680 * MiB;
constexpr size_t WS_INFO = 1684 * MiB;
constexpr size_t WS_END = 1688 * MiB;
constexpr int CW_BAR = 4096, CW_CNT = 8192;

constexpr int RING_BYTES = 131072;
constexpr int MISC_OFF = RING_BYTES;
constexpr int TAB_OFF = RING_BYTES + 64;
constexpr int LDS_BYTES = 147456;

typedef float f32x2_t __attribute__((ext_vector_type(2)));
typedef __bf16 bf16x2_t __attribute__((ext_vector_type(2)));
__device__ __forceinline__ unsigned cvt_pk_bf16(float lo, float hi) { const f32x2_t v = {lo, hi}; const bf16x2_t b = __builtin_convertvector(v, bf16x2_t); return __builtin_bit_cast(unsigned, b); }
__device__ __forceinline__ float bf_lo(unsigned w) { return __uint_as_float(w << 16); }
__device__ __forceinline__ float bf_hi(unsigned w) { return __uint_as_float(w & 0xffff0000u); }
__device__ __forceinline__ void unpack8(const u32x4 w, float (&f)[8]) { f[0] = bf_lo(w.x); f[1] = bf_hi(w.x); f[2] = bf_lo(w.y); f[3] = bf_hi(w.y); f[4] = bf_lo(w.z); f[5] = bf_hi(w.z); f[6] = bf_lo(w.w); f[7] = bf_hi(w.w); }
__device__ __forceinline__ void unpack8_f8(const u32x2 w, float (&f)[8]) {
    typedef float f32x2v __attribute__((ext_vector_type(2)));
    const f32x2v a = __builtin_amdgcn_cvt_pk_f32_fp8((int)w.x, false), b = __builtin_amdgcn_cvt_pk_f32_fp8((int)w.x, true), c = __builtin_amdgcn_cvt_pk_f32_fp8((int)w.y, false), d = __builtin_amdgcn_cvt_pk_f32_fp8((int)w.y, true);
    f[0] = a.x; f[1] = a.y; f[2] = b.x; f[3] = b.y; f[4] = c.x; f[5] = c.y; f[6] = d.x; f[7] = d.y;
}
__device__ __forceinline__ u32x4 pack8(const float (&f)[8]) { u32x4 o; o.x = cvt_pk_bf16(f[0], f[1]); o.y = cvt_pk_bf16(f[2], f[3]); o.z = cvt_pk_bf16(f[4], f[5]); o.w = cvt_pk_bf16(f[6], f[7]); return o; }
__device__ __forceinline__ int lane_id() { unsigned ones = ~0u; asm volatile("" : "+s"(ones)); return (int)__builtin_amdgcn_mbcnt_hi(ones, __builtin_amdgcn_mbcnt_lo(ones, 0u)); }
template <int O> __device__ __forceinline__ float xor_sw(float v) { return __int_as_float(__builtin_amdgcn_ds_swizzle(__float_as_int(v), 0x1f | (O << 10))); }
__device__ __forceinline__ float sum_x32(float v) { const auto r = __builtin_amdgcn_permlane32_swap(__float_as_uint(v), __float_as_uint(v), false, false); return __uint_as_float(r[0]) + __uint_as_float(r[1]); }
__device__ __forceinline__ float max_x32(float v) { const auto r = __builtin_amdgcn_permlane32_swap(__float_as_uint(v), __float_as_uint(v), false, false); return fmaxf(__uint_as_float(r[0]), __uint_as_float(r[1])); }
template <int CTRL> __device__ __forceinline__ float dpp_f(float v) { return __int_as_float(__builtin_amdgcn_update_dpp(0, __float_as_int(v), CTRL, 0xf, 0xf, true)); }
__device__ __forceinline__ float wave_sum(float v) { v += dpp_f<0xB1>(v); v += dpp_f<0x4E>(v); v += dpp_f<0x141>(v); v += dpp_f<0x140>(v); v += xor_sw<16>(v); return sum_x32(v); }
__device__ __forceinline__ float wave_max(float v) { v = fmaxf(v, dpp_f<0xB1>(v)); v = fmaxf(v, dpp_f<0x4E>(v)); v = fmaxf(v, dpp_f<0x141>(v)); v = fmaxf(v, dpp_f<0x140>(v)); v = fmaxf(v, xor_sw<16>(v)); return max_x32(v); }
__device__ __forceinline__ unsigned q8x4(float a, float b, float c, float d, float inv) {
    const unsigned t0 = __float_as_uint(__builtin_fmaf(a, inv, 12582912.0f)), t1 = __float_as_uint(__builtin_fmaf(b, inv, 12582912.0f));
    const unsigned t2 = __float_as_uint(__builtin_fmaf(c, inv, 12582912.0f)), t3 = __float_as_uint(__builtin_fmaf(d, inv, 12582912.0f));
    return __builtin_amdgcn_perm(__builtin_amdgcn_perm(t3, t2, 0x0c0c0400u), __builtin_amdgcn_perm(t1, t0, 0x0c0c0400u), 0x05040100u);
}
__device__ __forceinline__ unsigned f8x4(float a, float b, float c, float d, float inv) {
    int w = __builtin_amdgcn_cvt_pk_fp8_f32(a * inv, b * inv, 0, false); w = __builtin_amdgcn_cvt_pk_fp8_f32(c * inv, d * inv, w, true); return (unsigned)w;
}
#define XB_TMO      128
#define XB_XCNT(j)  (256  + 64 * (j))
#define XB_XSUB(j)  (1280 + 64 * (j))
#define XB_XGEN(j)  (2304 + 64 * (j))
#define XB_TOP      3328
#define XB_TOPGEN   3392
#define XCD_BAR_WORDS 3456
#define XB_SPIN_CAP (1u << 18)

__device__ __forceinline__ unsigned xb_ld(unsigned* p)              { return __hip_atomic_load(p, __ATOMIC_RELAXED, __HIP_MEMORY_SCOPE_AGENT); }
__device__ __forceinline__ unsigned xb_add(unsigned* p, unsigned v) { return __hip_atomic_fetch_add(p, v, __ATOMIC_RELAXED, __HIP_MEMORY_SCOPE_AGENT); }
__device__ __forceinline__ unsigned xb_xcc_id() { return (unsigned)__builtin_amdgcn_s_getreg((3 << 11) | 20) & 0xFu; }
#define XB_SPIN(cond, bar) do { unsigned _sp = 0; while (cond) { __builtin_amdgcn_s_sleep(1); \
    if ((++_sp & 255u) == 0u) { if (xb_ld(&(bar)[XB_TMO])) break; if (_sp > XB_SPIN_CAP) { atomicAdd(&(bar)[XB_TMO], 1u); break; } } } } while (0)

struct XcdBarrier { unsigned* bar; unsigned x; volatile LAS unsigned* st; };

__device__ __forceinline__ XcdBarrier xcd_barrier_post(unsigned* bar, volatile LAS unsigned* st) {
    XcdBarrier b; b.bar = bar; b.x = xb_xcc_id(); b.st = st;
    if (threadIdx.x == 0) (void)xb_add(&bar[XB_XCNT(b.x)], 1u);
    return b;
}
__device__ __forceinline__ void xcd_barrier_complete(unsigned* bar, unsigned x, unsigned& nloc, unsigned& nx) {
    const unsigned G = gridDim.x * gridDim.y * gridDim.z;
    unsigned sum, cnt, mine, sp = 0u;
    for (;;) {
        sum = 0u; cnt = 0u; mine = 0u;
#pragma unroll
        for (unsigned j = 0; j < 16; ++j) { const unsigned c = xb_ld(&bar[XB_XCNT(j)]); sum += c; cnt += (c > 0u) ? 1u : 0u; mine = (j == x) ? c : mine; }
        if (sum == G) break;
        __builtin_amdgcn_s_sleep(1);
        if ((++sp & 255u) == 0u) { if (xb_ld(&bar[XB_TMO])) break; if (sp > XB_SPIN_CAP) { atomicAdd(&bar[XB_TMO], 1u); break; } }
    }
    nloc = mine > 0u ? mine : 1u; nx = cnt > 0u ? cnt : 1u;
}
__device__ __forceinline__ void xcd_barrier(const XcdBarrier& b, int wave_s) {
    asm volatile("s_waitcnt vmcnt(0)" ::: "memory");
    __syncthreads();
    if (wave_s == 0 && lane_id() == 0) {
        unsigned* bar = b.bar; asm volatile("" : "+s"(bar));
        const unsigned bx_ = xb_xcc_id();
        __builtin_amdgcn_s_waitcnt(0);
        unsigned nloc = b.st[0], nx = b.st[1];
        if (nloc == 0u) { xcd_barrier_complete(bar, bx_, nloc, nx); b.st[0] = nloc; b.st[1] = nx; }
        const unsigned old = xb_add(&bar[XB_XSUB(bx_)], 1u);
        const unsigned gen = old / nloc;
        if (old + 1u == (gen + 1u) * nloc) {
            __builtin_amdgcn_fence(__ATOMIC_RELEASE, "agent");
            asm volatile("s_waitcnt vmcnt(0)" ::: "memory");
            const unsigned og = xb_add(&bar[XB_TOP], 1u);
            const unsigned tg = og / nx;
            if (og + 1u == (tg + 1u) * nx) xb_add(&bar[XB_TOPGEN], 1u);
            else XB_SPIN(xb_ld(&bar[XB_TOPGEN]) == tg, bar);
            __builtin_amdgcn_fence(__ATOMIC_ACQUIRE, "agent");
            xb_add(&bar[XB_XGEN(bx_)], 1u);
            asm volatile("s_waitcnt vmcnt(0)" ::: "memory");
        } else {
            XB_SPIN(xb_ld(&bar[XB_XGEN(bx_)]) == gen, bar);
            __builtin_amdgcn_fence(__ATOMIC_ACQUIRE, "agent");
            asm volatile("s_waitcnt vmcnt(0)" ::: "memory");
        }
    }
    __syncthreads();
}

namespace pg8 {
constexpr int BM = 256, BK = 64, HALF = 128, HTB = HALF * BK * 2, STAGE_BYTES = 8 * HTB, NXCD = 8, WGM = 8, K = 1024;
__device__ __forceinline__ int lds_byte(int r, int c) { const int st = (r >> 4) * 2 + (c >> 5), rr = r & 15, cc = c & 31, ob = rr * 64 + cc * 2; return st * 1024 + (ob ^ (((ob >> 9) & 1) << 5)); }
__device__ __forceinline__ void stage_rc(int b, int& R, int& C) { const int st = b / 1024, sb = b % 1024, swz = sb ^ (((sb >> 9) & 1) << 5); R = (st >> 1) * 16 + swz / 64; C = (st & 1) * 32 + (swz % 64) / 2; }
__device__ __forceinline__ int perm32(int rho) { const int n = rho >> 4, i = rho & 15; return 8 * (i >> 2) + 4 * n + (i & 3); }

struct Unit { int pm, pn, e, aux; };

template <bool I8_> struct DenseSched {
    static constexpr bool GATHER = false;
    static constexpr int RPB = I8_ ? 1024 : 2048;
    const char* A; const char* Bt; int nM, nN, nwg, G, c;
    __device__ __forceinline__ void init(const void* A_, const void* Bt_, int M, int N, int G_, int c_) { A = (const char*)A_; Bt = (const char*)Bt_; nM = M / BM; nN = N / BM; nwg = nM * nN; G = G_; c = c_; }
    __device__ __forceinline__ bool next(int i, Unit& u) const {
        const long L = (long)i * G + c; if (L >= nwg) return false;
        int wgid = (int)L; { const int q = nwg / NXCD, r = nwg % NXCD, xcd = wgid % NXCD, off = wgid / NXCD; wgid = (xcd < r ? xcd * (q + 1) : r * (q + 1) + (xcd - r) * q) + off; }
        const int nig = WGM * nN, gid = wgid / nig, fm = gid * WGM, gsz = (nM - fm) < WGM ? (nM - fm) : WGM;
        u.pm = fm + ((wgid % nig) % gsz); u.pn = (wgid % nig) / gsz; u.e = 0; u.aux = 0; return true;
    }
    __device__ __forceinline__ const char* aptr(const Unit& u) const { return A + (size_t)u.pm * (size_t)(BM * RPB); }
    __device__ __forceinline__ const char* bptr(const Unit& u) const { return Bt + (size_t)u.pn * (size_t)(BM * RPB); }
    __device__ __forceinline__ void gather(const Unit&, unsigned (&)[2][2], int) const {}
    __device__ __forceinline__ const int* list_src(const Unit&) const { return nullptr; }
    __device__ __forceinline__ void gather_lds(const Unit&, unsigned (&)[2][2], int, const LAS unsigned char*) const {}
};
template <bool GATHER_, bool I8_> struct MoeSched {
    static constexpr bool GATHER = GATHER_;
    static constexpr int RPB = I8_ ? 1024 : 2048;
    const char* A; const char* Bt; const int* list; const LAS int* tb; const LAS int* cn; int NN, total, G, vcu;
    __device__ __forceinline__ bool next(int i, Unit& u) const {
        const int L = i * G + vcu; if (L >= total) return false;
        const int mt = L / NN; u.pn = L - mt * NN; u.pm = mt;
        int e = 0;
        for (int j = 1; j < NEXP; ++j) e += (tb[j] <= mt) ? 1 : 0;
        u.e = e; u.aux = mt - tb[e]; return true;
    }
    __device__ __forceinline__ const char* aptr(const Unit& u) const { return GATHER ? A : A + (size_t)u.pm * (size_t)(BM * RPB); }
    __device__ __forceinline__ const char* bptr(const Unit& u) const { return Bt + ((size_t)u.e * NN + u.pn) * (size_t)(BM * RPB); }
    __device__ __forceinline__ const int* list_src(const Unit& u) const { return list + (size_t)u.e * T + u.aux * BM; }
    __device__ __forceinline__ void gather_lds(const Unit& u, unsigned (&g)[2][2], int tid, const LAS unsigned char* tokbuf) const {
        tid = (tid & ~63) | lane_id();
        const int c = cn[u.e] - u.aux * BM; const LAS int* tl = (const LAS int*)tokbuf;
#pragma unroll
        for (int i = 0; i < 2; ++i) { int R, C; stage_rc(tid * 16 + i * 8192, R, C);
#pragma unroll
            for (int h = 0; h < 2; ++h) { int r = h * HALF + R; r = r < c ? r : 0; g[h][i] = (unsigned)(tl[r] * RPB + C * 2); } }
    }
    __device__ __forceinline__ void gather(const Unit& u, unsigned (&g)[2][2], int tid) const {
        tid = (tid & ~63) | lane_id();
        const int c = cn[u.e];
#pragma unroll
        for (int i = 0; i < 2; ++i) { int R, C; stage_rc(tid * 16 + i * 8192, R, C);
#pragma unroll
            for (int h = 0; h < 2; ++h) { int slot = u.aux * BM + h * HALF + R; slot = slot < c ? slot : 0; const int tok = list[(size_t)u.e * T + slot]; g[h][i] = (unsigned)(tok * RPB + C * 2); } }
    }
};

template <int MODE  > struct EpiBf16 {
    static constexpr bool PERM = true, PREFETCH = (MODE == 3 || MODE == 0);
    __device__ __forceinline__ void prefetch(const Unit& u, LAS unsigned char* ebuf, int wid, int lane) const {
        if (MODE == 3) {
            if (wid == 1) __builtin_amdgcn_global_load_lds((const unsigned*)(bias + (size_t)u.e * D + 256 * u.pn + 4 * lane), (LAS unsigned*)(ebuf), 16, 0, 0);
            if (wid == 2) __builtin_amdgcn_global_load_lds((const unsigned*)(sb + (size_t)u.e * D + 256 * u.pn + 4 * lane), (LAS unsigned*)(ebuf + 1024), 16, 0, 0); }
        if (MODE == 0) {
            if (wid == 1) __builtin_amdgcn_global_load_lds((const unsigned*)(sb + 256 * u.pn + 4 * lane), (LAS unsigned*)(ebuf + 1024), 16, 0, 0);
            if (wid == 2) __builtin_amdgcn_global_load_lds((const unsigned*)(sa + 256 * u.pm + 4 * lane), (LAS unsigned*)(ebuf + 2048), 16, 0, 0); }
    }
    bf16_t* O; int ldc; const bf16_t* res; const float* bias; float alpha;
    const float* sa; const float* sb;
    __device__ __forceinline__ void operator()(const i32x4 (&acc)[2][2][4][2], const Unit& u, int wr, int wc, int fr, int fq, const LAS unsigned char* ebuf) const {
        { const int l2 = lane_id(); fr = l2 & 15; fq = l2 >> 4; }
        const int row0 = u.pm * BM + wr * 64 + fr, col0 = u.pn * BM + wc * 32 + 8 * fq;
        f32x4 sv[2][2];
#pragma unroll
        for (int bj = 0; bj < 2; ++bj)
#pragma unroll
            for (int n = 0; n < 2; ++n) sv[bj][n] = (MODE == 0) ? *(const LAS f32x4*)(ebuf + 1024 + 4 * (64 * wc + 16 * fq + 8 * bj + 4 * n)) : *(const f32x4*)(sb + col0 + bj * HALF + 4 * n);
        float rsv[2][4];
#pragma unroll
        for (int ai = 0; ai < 2; ++ai)
#pragma unroll
            for (int m = 0; m < 4; ++m) rsv[ai][m] = (MODE == 0) ? ((const LAS float*)ebuf)[512 + wr * 64 + fr + ai * HALF + m * 16] : sa[row0 + ai * HALF + m * 16];
#pragma unroll
        for (int ai = 0; ai < 2; ++ai)
#pragma unroll
            for (int m = 0; m < 4; ++m) { const int row = row0 + ai * HALF + m * 16; const float rs = rsv[ai][m]; const size_t ro = (size_t)row * ldc + col0;
#pragma unroll
                for (int bj = 0; bj < 2; ++bj) { float v[8];
#pragma unroll
                    for (int i = 0; i < 4; ++i) { v[i] = (float)acc[ai][bj][m][0][i] * (rs * sv[bj][0][i]); v[4 + i] = (float)acc[ai][bj][m][1][i] * (rs * sv[bj][1][i]); }
                    if (MODE == 0) *(u32x4*)(O + (size_t)row * ldc + u.pn * BM + 64 * wc + 16 * fq + 8 * bj) = pack8(v);
                    else *(u32x4*)(O + ro + bj * HALF) = pack8(v); } }
    }
    __device__ __forceinline__ void operator()(const f32x4 (&acc)[2][2][4][2], const Unit& u, int wr, int wc, int fr, int fq, const LAS unsigned char* ebuf) const {
        { const int l2 = lane_id(); fr = l2 & 15; fq = l2 >> 4; }
        const int row0 = u.pm * BM + wr * 64 + fr, col0 = u.pn * BM + wc * 32 + 8 * fq;
        f32x4 bv[2][2];
#pragma unroll
        for (int bj = 0; bj < 2; ++bj)
#pragma unroll
            for (int n = 0; n < 2; ++n) bv[bj][n] = (MODE == 3) ? *(const LAS f32x4*)(ebuf + 4 * (64 * wc + 16 * fq + 8 * bj + 4 * n)) * 16.0f
                                                  : (MODE == 2) ? *(const f32x4*)(bias + (size_t)u.e * D + col0 + bj * HALF + 4 * n) : (f32x4){0.f, 0.f, 0.f, 0.f};
        f32x4 cs[2][2];
#pragma unroll
        for (int bj = 0; bj < 2; ++bj)
#pragma unroll
            for (int n = 0; n < 2; ++n) cs[bj][n] = (MODE == 3) ? *(const LAS f32x4*)(ebuf + 1024 + 4 * (64 * wc + 16 * fq + 8 * bj + 4 * n))
                                                  : (MODE == 2) ? *(const f32x4*)(sb + (size_t)u.e * D + col0 + bj * HALF + 4 * n) : (f32x4){1.f, 1.f, 1.f, 1.f};
#pragma unroll
        for (int ai = 0; ai < 2; ++ai) {
            u32x4 rr[4][2];
            if (MODE == 1) {
#pragma unroll
                for (int m = 0; m < 4; ++m)
#pragma unroll
                    for (int bj = 0; bj < 2; ++bj) rr[m][bj] = *(const u32x4*)(res + (size_t)(row0 + ai * HALF + m * 16) * ldc + col0 + bj * HALF); }
#pragma unroll
            for (int m = 0; m < 4; ++m) { const size_t ro = (size_t)(row0 + ai * HALF + m * 16) * ldc + col0;
                u32x2 w8a;
#pragma unroll
                for (int bj = 0; bj < 2; ++bj) { f32x4 v0 = acc[ai][bj][m][0], v1 = acc[ai][bj][m][1];
                    if (MODE >= 2) { v0 = v0 * cs[bj][0]; v1 = v1 * cs[bj][1]; }
                    v0 += bv[bj][0]; v1 += bv[bj][1];
                    if (MODE == 1) { const u32x4 r = rr[m][bj];
                        v0[0] += alpha * bf_lo(r.x); v0[1] += alpha * bf_hi(r.x); v0[2] += alpha * bf_lo(r.y); v0[3] += alpha * bf_hi(r.y);
                        v1[0] += alpha * bf_lo(r.z); v1[1] += alpha * bf_hi(r.z); v1[2] += alpha * bf_lo(r.w); v1[3] += alpha * bf_hi(r.w); }
                    if (MODE == 3) { u32x2 w8; w8.x = f8x4(v0[0], v0[1], v0[2], v0[3], 1.0f); w8.y = f8x4(v1[0], v1[1], v1[2], v1[3], 1.0f);
                        if (bj == 0) w8a = w8;
                        else { u32x4 w16; w16.x = w8a.x; w16.y = w8a.y; w16.z = w8.x; w16.w = w8.y;
                            *(u32x4*)((unsigned char*)O + (size_t)(row0 + ai * HALF + m * 16) * ldc + u.pn * BM + 64 * wc + 16 * fq) = w16; } }
                    else { u32x4 w; w.x = cvt_pk_bf16(v0[0], v0[1]); w.y = cvt_pk_bf16(v0[2], v0[3]); w.z = cvt_pk_bf16(v1[0], v1[1]); w.w = cvt_pk_bf16(v1[2], v1[3]);
                        *(u32x4*)(O + ro + bj * HALF) = w; } } } }
    }
};
struct EpiSwiGLU {
    static constexpr bool PERM = false, PREFETCH = true;
    __device__ __forceinline__ void prefetch(const Unit& u, LAS unsigned char* ebuf, int wid, int lane) const {
        if (wid == 1) __builtin_amdgcn_global_load_lds((const unsigned*)(bias + (size_t)u.e * 2048 + 256 * u.pn + 4 * lane), (LAS unsigned*)(ebuf), 16, 0, 0);
        if (wid == 2) __builtin_amdgcn_global_load_lds((const unsigned*)(sb + (size_t)u.e * 2048 + 256 * u.pn + 4 * lane), (LAS unsigned*)(ebuf + 1024), 16, 0, 0);
        if (wid == 3) __builtin_amdgcn_global_load_lds((const unsigned*)(sxs + (size_t)u.e * T + u.aux * BM + 4 * lane), (LAS unsigned*)(ebuf + 2048), 16, 0, 0);
    }
    bf16_t* O; const float* bias;
    const float* sb; const float* sxs;
    __device__ __forceinline__ void operator()(const i32x4 (&acc)[2][2][4][2], const Unit& u, int wr, int wc, int fr, int fq, const LAS unsigned char* ebuf) const {
        { const int l2 = lane_id(); fr = l2 & 15; fq = l2 >> 4; }
        const int row0 = u.pm * BM + wr * 64 + fr;
        float rs[2][4];
#pragma unroll
        for (int ai = 0; ai < 2; ++ai)
#pragma unroll
            for (int m = 0; m < 4; ++m) rs[ai][m] = ((const LAS float*)ebuf)[512 + ai * HALF + wr * 64 + m * 16 + fr];
        int wst[2][4];
#pragma unroll
        for (int bj = 0; bj < 2; ++bj) {
            const int g32l = 4 * bj + wc, j0l = 32 * wc + 8 * fq + 4 * bj, j0 = 128 * u.pn + 32 * wc + 8 * fq;
            const f32x4 b0 = *(const LAS f32x4*)(ebuf + 8 * j0l), b1 = *(const LAS f32x4*)(ebuf + 8 * j0l + 16);
            const float bg[4] = {b0[0], b0[2], b1[0], b1[2]}, bl[4] = {b0[1] + 1.0f, b0[3] + 1.0f, b1[1] + 1.0f, b1[3] + 1.0f};
            const f32x4 sg = *(const LAS f32x4*)(ebuf + 1024 + 4 * (32 * g32l + 4 * fq)), sl = *(const LAS f32x4*)(ebuf + 1024 + 4 * (32 * g32l + 16 + 4 * fq));
            typedef float f32x2v __attribute__((ext_vector_type(2)));
            const f32x2v sg2[2] = {{sg[0], sg[1]}, {sg[2], sg[3]}}, sl2[2] = {{sl[0], sl[1]}, {sl[2], sl[3]}}, bg2[2] = {{bg[0], bg[1]}, {bg[2], bg[3]}}, bl2[2] = {{bl[0], bl[1]}, {bl[2], bl[3]}};
#pragma unroll
            for (int ai = 0; ai < 2; ++ai)
#pragma unroll
                for (int m = 0; m < 4; ++m) { float a[4]; const float rsm = rs[ai][m];
#pragma unroll
                    for (int h2 = 0; h2 < 2; ++h2) {
                        const f32x2v ga = {(float)acc[ai][bj][m][0][2 * h2], (float)acc[ai][bj][m][0][2 * h2 + 1]}, la = {(float)acc[ai][bj][m][1][2 * h2], (float)acc[ai][bj][m][1][2 * h2 + 1]};
                        f32x2v g = ga * (sg2[h2] * rsm) + bg2[h2], l = la * (sl2[h2] * rsm) + bl2[h2];
                        g.x = fminf(g.x, 7.0f); g.y = fminf(g.y, 7.0f); l.x = fminf(fmaxf(l.x, -6.0f), 8.0f); l.y = fminf(fmaxf(l.y, -6.0f), 8.0f);
                        const f32x2v z = g * (-1.702f * 1.4426950408889634f);
                        f32x2v den; den.x = __builtin_amdgcn_exp2f(z.x); den.y = __builtin_amdgcn_exp2f(z.y); den = den + 1.0f;
                        f32x2v r; r.x = __builtin_amdgcn_rcpf(den.x); r.y = __builtin_amdgcn_rcpf(den.y);
                        const f32x2v o = (g * r) * l;
                        a[2 * h2] = o.x; a[2 * h2 + 1] = o.y; }
                    int w = __builtin_amdgcn_cvt_pk_fp8_f32(a[0], a[1], 0, false); w = __builtin_amdgcn_cvt_pk_fp8_f32(a[2], a[3], w, true);
                    if (bj == 0) wst[ai][m] = w;
                    else { u32x2 w2; w2.x = (unsigned)wst[ai][m]; w2.y = (unsigned)w; *(u32x2*)((unsigned char*)O + (size_t)(row0 + ai * HALF + m * 16) * D + j0) = w2; } }
        }
    }
    __device__ __forceinline__ void operator()(const f32x4 (&acc)[2][2][4][2], const Unit& u, int wr, int wc, int fr, int fq, const LAS unsigned char* ebuf) const {
        { const int l2 = lane_id(); fr = l2 & 15; fq = l2 >> 4; }
        const int row0 = u.pm * BM + wr * 64 + fr;
#pragma unroll
        for (int bj = 0; bj < 2; ++bj) {
            const int j0 = 16 * (8 * u.pn + 4 * bj + wc) + 4 * fq;
            const f32x4 b0 = *(const f32x4*)(bias + (size_t)u.e * 2048 + 2 * j0), b1 = *(const f32x4*)(bias + (size_t)u.e * 2048 + 2 * j0 + 4);
            const float bg[4] = {b0[0], b0[2], b1[0], b1[2]}, bl[4] = {b0[1], b0[3], b1[1], b1[3]};
#pragma unroll
            for (int ai = 0; ai < 2; ++ai)
#pragma unroll
                for (int m = 0; m < 4; ++m) { float a[4];
#pragma unroll
                    for (int i = 0; i < 4; ++i) { float g = acc[ai][bj][m][0][i] + bg[i], l = acc[ai][bj][m][1][i] + bl[i];
                        g = fminf(g, 7.0f); l = fminf(fmaxf(l, -7.0f), 7.0f);
                        const float sg = __builtin_amdgcn_rcpf(1.0f + __expf(-1.702f * g));
                        a[i] = g * sg * (l + 1.0f); }
                    u32x2 w; w.x = cvt_pk_bf16(a[0], a[1]); w.y = cvt_pk_bf16(a[2], a[3]);
                    *(u32x2*)(O + (size_t)(row0 + ai * HALF + m * 16) * D + j0) = w; }
        }
    }
};

__device__ __forceinline__ f32x4 mma16(bf16x8 a, bf16x8 b, f32x4 c) { return __builtin_amdgcn_mfma_f32_16x16x32_bf16(a, b, c, 0, 0, 0); }
__device__ __forceinline__ i32x4 mma16(bf16x8 a, bf16x8 b, i32x4 c) { return __builtin_amdgcn_mfma_i32_16x16x64_i8(__builtin_bit_cast(i32x4, a), __builtin_bit_cast(i32x4, b), c, 0, 0, 0); }
struct NoHook { __device__ __forceinline__ void operator()(int) const {} };
template <int DT  , class Epi, class Sched, class Hook = NoHook>
__device__ __forceinline__ void gemm_phase(LAS unsigned char* lds, const Sched& S, const Epi& E, int wave_s, LAS unsigned char* aux  ,
                                           const Hook& H = Hook()  ) {
    constexpr bool GATHER = Sched::GATHER;
    constexpr int RPB = DT ? 1024 : 2048;
    typedef typename std::conditional<DT == 1, i32x4, f32x4>::type acc_t;
    int lane_ = lane_id(); asm volatile("" : "+v"(lane_));
    asm volatile("" : "+s"(wave_s));
    const int tid = wave_s * 64 + lane_;
    const int wid = wave_s, lane = tid & 63, wr = wid >> 2, wc = wid & 3, fr = lane & 15, fq = lane >> 4;
    constexpr int nt = RPB / 128;
    unsigned voffA[2], voffB[2];
#pragma unroll
    for (int i = 0; i < 2; ++i) { int R, C; stage_rc(tid * 16 + i * 8192, R, C); const int Rb = Epi::PERM ? ((R & ~31) + perm32(R & 31)) : R;
        voffA[i] = (unsigned)(R * RPB + C * 2); voffB[i] = (unsigned)(Rb * RPB + C * 2); }
    constexpr size_t kstep = (size_t)(BK * 2);
    constexpr size_t hstep = (size_t)HALF * RPB;
    const unsigned ldsw = (unsigned)wid * 1024u;
    const int aoff = lds_byte(wr * 64 + fr, fq * 8), boff = lds_byte(wc * 32 + fr, fq * 8);
    unsigned gA[2][2] = {{0u, 0u}, {0u, 0u}};
#define PG8_SA(b, h) (((b) * 2 + (h)) * HTB)
#define PG8_SB(b, h) ((4 + (b) * 2 + (h)) * HTB)
#define PG8_STAGE(bufoff, gbase, voff) do { _Pragma("unroll") for (int _i = 0; _i < 2; ++_i) \
        __builtin_amdgcn_global_load_lds((const unsigned*)((const char*)(gbase) + (voff)[_i]), (LAS unsigned*)(lds + (bufoff) + ldsw + _i * 8192), 16, 0, 0); } while (0)
#define PG8_STAGE_A(bufoff, h, abase) do { _Pragma("unroll") for (int _i = 0; _i < 2; ++_i) { \
        const char* _src = GATHER ? ((const char*)(abase) + gA[h][_i]) : ((const char*)(abase) + (size_t)(h) * hstep + voffA[_i]); \
        __builtin_amdgcn_global_load_lds((const unsigned*)_src, (LAS unsigned*)(lds + (bufoff) + ldsw + _i * 8192), 16, 0, 0); } } while (0)
#define PG8_LD2(dst, off) do { if constexpr (DT == 2) { const i32x4 _lo = *(const LAS i32x4*)(lds + (off)), _hi = *(const LAS i32x4*)(lds + (off) + 1024); (dst).f8 = __builtin_shufflevector(_lo, _hi, 0, 1, 2, 3, 4, 5, 6, 7); } \
        else { (dst).h[0] = *(const LAS bf16x8*)(lds + (off)); (dst).h[1] = *(const LAS bf16x8*)(lds + (off) + 1024); } } while (0)
#define PG8_LDA(dst, b, h) do { _Pragma("unroll") for (int m = 0; m < 4; ++m) PG8_LD2(dst[m], PG8_SA(b, h) + aoff + m * 2048); } while (0)
#define PG8_LDB(dst, b, h) do { _Pragma("unroll") for (int n = 0; n < 2; ++n) PG8_LD2(dst[n], PG8_SB(b, h) + boff + n * 2048); } while (0)
#define PG8_MMA(ai, bj, At, Bt) do { __builtin_amdgcn_s_setprio(1); _Pragma("unroll") for (int m = 0; m < 4; ++m) _Pragma("unroll") for (int n = 0; n < 2; ++n) { \
        if constexpr (DT == 2) acc[ai][bj][m][n] = __builtin_amdgcn_mfma_scale_f32_16x16x128_f8f6f4(Bt[n].f8, At[m].f8, acc[ai][bj][m][n], 0, 0, 0, 0x7f7f7f7f, 0, 0x7f7f7f7f); \
        else { _Pragma("unroll") for (int k = 0; k < 2; ++k) acc[ai][bj][m][n] = mma16(Bt[n].h[k], At[m].h[k], acc[ai][bj][m][n]); } \
        if constexpr (DT == 2) asm volatile("" : "+v"(acc[ai][bj][m][n]));   } \
        __builtin_amdgcn_s_setprio(0); } while (0)
#define PG8_WAIT_V(n) asm volatile("s_waitcnt vmcnt(" #n ")" ::: "memory")
#define PG8_WAIT_L(n) asm volatile("s_waitcnt lgkmcnt(" #n ")" ::: "memory")
#define PG8_BAR __builtin_amdgcn_s_barrier()
#define PG8_SCHED __builtin_amdgcn_sched_barrier(0)
    Unit cur, nxt; int ui = 0;
    if (!S.next(0, cur)) { H(-1); return; }
    acc_t acc[2][2][4][2];
#pragma unroll
    for (int a = 0; a < 2; ++a)
#pragma unroll
        for (int b = 0; b < 2; ++b)
#pragma unroll
            for (int m = 0; m < 4; ++m)
#pragma unroll
                for (int n = 0; n < 2; ++n) acc[a][b][m][n] = (acc_t){0, 0, 0, 0};
    struct Frag { bf16x8 h[2]; i32x8 f8; };
    Frag At[4], B0[2], B1[2];
    const char* cA = S.aptr(cur); const char* cB = S.bptr(cur);
    if (GATHER) S.gather(cur, gA, tid);
    PG8_STAGE(PG8_SB(0, 0), cB, voffB); PG8_STAGE(PG8_SB(0, 1), cB + hstep, voffB); PG8_STAGE_A(PG8_SA(0, 0), 0, cA); PG8_STAGE_A(PG8_SA(0, 1), 1, cA);
    if (wr == 1) PG8_BAR;
    PG8_WAIT_V(2); PG8_BAR;
    PG8_STAGE(PG8_SB(1, 0), cB + kstep, voffB); PG8_STAGE_A(PG8_SA(1, 0), 0, cA + kstep); PG8_STAGE(PG8_SB(1, 1), cB + hstep + kstep, voffB);
    PG8_WAIT_V(6); PG8_BAR;
    for (;;) {
        const bool has_next = S.next(ui + 1, nxt);
        const char* nA = has_next ? S.aptr(nxt) : cA; const char* nB = has_next ? S.bptr(nxt) : cB;
        {
            if constexpr (GATHER) { if (has_next && wid == 0) __builtin_amdgcn_global_load_lds((const unsigned*)(S.list_src(nxt) + 4 * lane), (LAS unsigned*)(aux + ((ui + 1) & 1) * 1024), 16, 0, 0); }
            if constexpr (Epi::PREFETCH) E.prefetch(cur, aux + 2048 + (ui & 1) * 3072, wid, lane);
        }
        for (int t = 0; t < nt; t += 2) {
            const bool last = (t == nt - 2);
            const char* a1 = cA + (size_t)(t + 1) * kstep;
            const char* a2 = last ? nA : cA + (size_t)(t + 2) * kstep; const char* b2 = last ? nB : cB + (size_t)(t + 2) * kstep;
            const char* a3 = a2 + kstep; const char* b3 = b2 + kstep;
            PG8_LDB(B0, 0, 0); PG8_LDB(B1, 0, 1); PG8_SCHED; PG8_LDA(At, 0, 0); PG8_STAGE_A(PG8_SA(1, 1), 1, a1);
            if (GATHER) { if (last && has_next) S.gather_lds(nxt, gA, tid, aux + ((ui + 1) & 1) * 1024); }
            PG8_WAIT_V(8); PG8_WAIT_L(0); PG8_BAR; PG8_MMA(0, 0, At, B0); PG8_MMA(0, 1, At, B1); PG8_BAR; PG8_SCHED;
            PG8_LDA(At, 0, 1); PG8_STAGE(PG8_SB(0, 0), b2, voffB); PG8_STAGE(PG8_SB(0, 1), b2 + hstep, voffB); PG8_STAGE_A(PG8_SA(0, 0), 0, a2);
            PG8_WAIT_V(8); PG8_WAIT_L(0); PG8_BAR; PG8_MMA(1, 0, At, B0); PG8_MMA(1, 1, At, B1); PG8_BAR; PG8_SCHED;
            PG8_LDB(B0, 1, 0); PG8_LDB(B1, 1, 1); PG8_SCHED; PG8_LDA(At, 1, 0); PG8_STAGE_A(PG8_SA(0, 1), 1, a2);
            PG8_WAIT_V(8); PG8_WAIT_L(0); PG8_BAR; PG8_MMA(0, 0, At, B0); PG8_MMA(0, 1, At, B1); PG8_BAR; PG8_SCHED;
            PG8_LDA(At, 1, 1); PG8_STAGE(PG8_SB(1, 0), b3, voffB); PG8_STAGE(PG8_SB(1, 1), b3 + hstep, voffB); PG8_STAGE_A(PG8_SA(1, 0), 0, a3);
            PG8_WAIT_V(8); PG8_WAIT_L(0); PG8_BAR; PG8_MMA(1, 0, At, B0); PG8_MMA(1, 1, At, B1); PG8_BAR; PG8_SCHED;
        }
        if (wr == 0) PG8_BAR;
        E(acc, cur, wr, wc, fr, fq, aux + 2048 + (ui & 1) * 3072);
        H(ui);
        if (!has_next) break;
#pragma unroll
        for (int a = 0; a < 2; ++a)
#pragma unroll
            for (int b = 0; b < 2; ++b)
#pragma unroll
                for (int m = 0; m < 4; ++m)
#pragma unroll
                    for (int n = 0; n < 2; ++n) acc[a][b][m][n] = (acc_t){0, 0, 0, 0};
        cur = nxt; cA = nA; cB = nB; ++ui;
        if (wr == 1) PG8_BAR;
    }
    PG8_WAIT_V(0);
    PG8_BAR;
    H(-1);
#undef PG8_SA
#undef PG8_SB
#undef PG8_STAGE
#undef PG8_STAGE_A
#undef PG8_LDA
#undef PG8_LDB
#undef PG8_MMA
#undef PG8_WAIT_V
#undef PG8_WAIT_L
#undef PG8_BAR
#undef PG8_SCHED
}
}

template <int MODE  >
__device__ __forceinline__ void tconv_item(const float* W, int N, bf16_t* Bt, int kb, int nb, int lane) {
    const int k0 = kb * 64, n = nb * 64 + lane;
    float v[64];
#pragma unroll
    for (int i = 0; i < 64; ++i) v[i] = W[(size_t)(k0 + i) * N + n];
    int row = n;
    if (MODE == 1) { const int j = n >> 1, par = n & 1; row = ((j >> 4) << 5) + (par << 4) + (j & 15); }
    u32x4* dst = (u32x4*)(Bt + (size_t)row * D + k0);
#pragma unroll
    for (int c = 0; c < 8; ++c) { u32x4 o; o.x = cvt_pk_bf16(v[8 * c], v[8 * c + 1]); o.y = cvt_pk_bf16(v[8 * c + 2], v[8 * c + 3]); o.z = cvt_pk_bf16(v[8 * c + 4], v[8 * c + 5]); o.w = cvt_pk_bf16(v[8 * c + 6], v[8 * c + 7]); dst[c] = o; }
}
template <bool PERMGL, bool FP8>
__device__ __forceinline__ void q8_cols_item(const float* W, int N, int n0, unsigned char* Bq, float* sc_out, LAS float* AM, int par, int wave, int lane) {
    const int n = n0 + lane;
    const float* Wp = W + (size_t)(128 * wave) * N + n;
    float v[128]; float am = 0.f;
#pragma unroll
    for (int i = 0; i < 128; ++i) v[i] = Wp[(size_t)i * N];
    __builtin_amdgcn_sched_barrier(0);
#pragma unroll
    for (int i = 0; i < 128; ++i) am = fmaxf(am, fabsf(v[i]));
    AM[(par * 8 + wave) * 64 + lane] = am;
    __syncthreads();
#pragma unroll
    for (int w = 0; w < 8; ++w) am = fmaxf(am, AM[(par * 8 + w) * 64 + lane]);
    const float sc = am > 0.f ? am * (FP8 ? (1.0f / 256.0f) : (1.0f / 127.0f)) : 1.0f, inv = 1.0f / sc;
    int row = n;
    if (PERMGL) { const int j = n >> 1, pr = n & 1, o = j & 127; row = ((j >> 7) << 8) + (((o >> 2) & 1) << 7) + ((o >> 5) << 5) + (pr << 4) + (((o >> 3) & 3) << 2) + (o & 3); }
    if (!PERMGL) { const int o = n & 255; row = ((n >> 8) << 8) + (((o >> 3) & 1) << 7) + ((o >> 6) << 5) + (((o >> 4) & 3) << 3) + (o & 7); }
    auto xq = [](unsigned x) { return (unsigned)__builtin_amdgcn_update_dpp(0, (int)x, 0xB1, 0xf, 0xf, true); };
    const bool odd = lane & 1;
    const int rowp = (int)xq((unsigned)row);
    unsigned char* plo = Bq + (size_t)(odd ? rowp : row) * 1024 + 128 * wave + (odd ? 16 : 0);
    unsigned char* phi = Bq + (size_t)(odd ? row : rowp) * 1024 + 128 * wave + (odd ? 16 : 0);
    auto packc = [&](int c) { u32x4 o;
        if (FP8) { o.x = f8x4(v[16 * c], v[16 * c + 1], v[16 * c + 2], v[16 * c + 3], inv); o.y = f8x4(v[16 * c + 4], v[16 * c + 5], v[16 * c + 6], v[16 * c + 7], inv);
                   o.z = f8x4(v[16 * c + 8], v[16 * c + 9], v[16 * c + 10], v[16 * c + 11], inv); o.w = f8x4(v[16 * c + 12], v[16 * c + 13], v[16 * c + 14], v[16 * c + 15], inv); }
        else { o.x = q8x4(v[16 * c], v[16 * c + 1], v[16 * c + 2], v[16 * c + 3], inv); o.y = q8x4(v[16 * c + 4], v[16 * c + 5], v[16 * c + 6], v[16 * c + 7], inv);
               o.z = q8x4(v[16 * c + 8], v[16 * c + 9], v[16 * c + 10], v[16 * c + 11], inv); o.w = q8x4(v[16 * c + 12], v[16 * c + 13], v[16 * c + 14], v[16 * c + 15], inv); }
        return o; };
#pragma unroll
    for (int j = 0; j < 4; ++j) { const u32x4 p0 = packc(2 * j), p1 = packc(2 * j + 1);
        u32x4 snd, rcv;
#pragma unroll
        for (int q = 0; q < 4; ++q) { snd[q] = odd ? p0[q] : p1[q]; rcv[q] = xq(snd[q]); }
        u32x4 a, b;
#pragma unroll
        for (int q = 0; q < 4; ++q) { a[q] = odd ? rcv[q] : p0[q]; b[q] = odd ? p1[q] : rcv[q]; }
        *(u32x4*)(plo + 32 * j) = a; *(u32x4*)(phi + 32 * j) = b; }
    if (wave == 0) sc_out[PERMGL ? row : n] = FP8 ? sc * 16.0f : sc;
}
__device__ __forceinline__ void fold_item(const float* pool_w, const float* pool_scale, const float* w_out, bf16_t* BtOut, int item, int lane) {
    const int kq = item & 7, nb = (item >> 3) & 15, g = (item >> 7) & 3, i = item >> 9;
    const int n = nb * 64 + lane, kk0 = kq * 16;
    const float* pw = pool_w + ((size_t)(i * 4 + g) * 128 + kk0) * 128;
    const float* sc = pool_scale + i * 512 + g * 128;
    const float* wo = w_out + ((size_t)i * 1024 + g * 128) * D + n;
    float a0[16], a1[16];
    { const float s0 = sc[lane], s1 = sc[64 + lane];
#pragma unroll
      for (int k = 0; k < 16; ++k) { a0[k] = pw[k * 128 + lane] * s0; a1[k] = pw[k * 128 + 64 + lane] * s1; } }
    float acc[16];
#pragma unroll
    for (int k = 0; k < 16; ++k) acc[k] = 0.f;
#pragma unroll 8
    for (int c = 0; c < 64; ++c) { const float w0 = wo[(size_t)c * D], w1 = wo[(size_t)(c + 64) * D];
#pragma unroll
        for (int k = 0; k < 16; ++k) { acc[k] += __int_as_float(__builtin_amdgcn_readlane(__float_as_int(a0[k]), c)) * w0; acc[k] += __int_as_float(__builtin_amdgcn_readlane(__float_as_int(a1[k]), c)) * w1; } }
    u32x4* dst = (u32x4*)(BtOut + ((size_t)i * 1024 + n) * D + g * 128 + kk0);
    u32x4 o0, o1;
    o0.x = cvt_pk_bf16(acc[0], acc[1]); o0.y = cvt_pk_bf16(acc[2], acc[3]); o0.z = cvt_pk_bf16(acc[4], acc[5]); o0.w = cvt_pk_bf16(acc[6], acc[7]);
    o1.x = cvt_pk_bf16(acc[8], acc[9]); o1.y = cvt_pk_bf16(acc[10], acc[11]); o1.z = cvt_pk_bf16(acc[12], acc[13]); o1.w = cvt_pk_bf16(acc[14], acc[15]);
    dst[0] = o0; dst[1] = o1;
}

__device__ __forceinline__ bf16x8 ld16(const char* base, unsigned off) { return *(const bf16x8*)(base + off); }
struct TileD { int kb, d; float flim; bool valid; };
__device__ __forceinline__ void attn_load(const char* kp_base, const char* vp_base, const TileD& t_, bf16x8 (&kf)[2][2], bf16x8 (&vr)[4], int lane) {
    const int c = lane & 15, g = lane >> 4;
    TileD t = t_; asm volatile("" : "+s"(t.kb));
    if (!t.valid) {
#pragma unroll
        for (int j = 0; j < 4; ++j) { kf[j >> 1][j & 1] = (bf16x8){0, 0, 0, 0, 0, 0, 0, 0}; vr[j] = (bf16x8){0, 0, 0, 0, 0, 0, 0, 0}; }
        return; }
#pragma unroll
    for (int kt2 = 0; kt2 < 2; ++kt2) { const int kp = t.kb + t.d * (16 * kt2 + c);
        const unsigned off = (unsigned)kp * (unsigned)(ODD_IN * 2) + 16u * g;
        kf[kt2][0] = ld16(kp_base, off); kf[kt2][1] = ld16(kp_base, off + 64u); }
#pragma unroll
    for (int j = 0; j < 4; ++j) { const int ch = lane + 64 * j, row = ch >> 3, cc = ch & 7; const int kp = t.kb + t.d * row;
        vr[j] = ld16(vp_base, (unsigned)kp * (unsigned)(ODD_IN * 2) + 16u * cc); }
}
__device__ __forceinline__ void attn_vwrite(const bf16x8 (&vr)[4], LAS unsigned char* vbuf, int lane) {
#pragma unroll
    for (int j = 0; j < 4; ++j) { const int ch = lane + 64 * j; *(LAS bf16x8*)(vbuf + (ch >> 3) * 160 + (ch & 7) * 16) = vr[j]; }
}
typedef short s16x4 __attribute__((ext_vector_type(4)));
__device__ __forceinline__ void attn_vfrag(const LAS unsigned char* vbuf, bf16x8 (&vf)[4], int lane) {
    const LAS unsigned char* p = vbuf + (4 * (lane >> 4) + ((lane >> 2) & 3)) * 160 + 8 * (lane & 3);
#pragma unroll
    for (int mt = 0; mt < 4; ++mt) { const s16x4 a = __builtin_amdgcn_ds_read_tr16_b64_v4i16((LAS s16x4*)(p + 32 * mt)), b = __builtin_amdgcn_ds_read_tr16_b64_v4i16((LAS s16x4*)(p + 2560 + 32 * mt));
        vf[mt] = __builtin_shufflevector(a, b, 0, 1, 2, 3, 4, 5, 6, 7); }
}
template <int NH, class InitF>
__device__ __forceinline__ void attn_core(const bf16x8 (&kf)[2][2], const LAS unsigned char* vbuf, const InitF& initf  ,
                                          const bf16x8 (&bq)[NH][2], float (&m)[NH], float (&l)[NH], f32x4 (&O)[NH][4], int lane) {
    bf16x8 vf[4];
    attn_vfrag(vbuf, vf, lane);
#pragma unroll
    for (int hq = 0; hq < NH; ++hq) {
        f32x4 s0 = initf(hq, 0), s1 = initf(hq, 1);
        s0 = __builtin_amdgcn_mfma_f32_16x16x32_bf16(kf[0][0], bq[hq][0], s0, 0, 0, 0); s0 = __builtin_amdgcn_mfma_f32_16x16x32_bf16(kf[0][1], bq[hq][1], s0, 0, 0, 0);
        s1 = __builtin_amdgcn_mfma_f32_16x16x32_bf16(kf[1][0], bq[hq][0], s1, 0, 0, 0); s1 = __builtin_amdgcn_mfma_f32_16x16x32_bf16(kf[1][1], bq[hq][1], s1, 0, 0, 0);
        float mx = fmaxf(fmaxf(fmaxf(s0[0], s0[1]), fmaxf(s0[2], s0[3])), fmaxf(fmaxf(s1[0], s1[1]), fmaxf(s1[2], s1[3])));
        mx = fmaxf(mx, xor_sw<16>(mx)); mx = max_x32(mx);
        const float mn = fmaxf(m[hq], mx), corr = __builtin_amdgcn_exp2f(m[hq] - mn); m[hq] = mn;
        float p[8], ps = 0.f;
#pragma unroll
        for (int i = 0; i < 8; ++i) { p[i] = __builtin_amdgcn_exp2f((i < 4 ? s0[i & 3] : s1[i & 3]) - mn); ps += p[i]; }
        l[hq] = l[hq] * corr + ps;
        u32x4 pw; pw.x = cvt_pk_bf16(p[0], p[1]); pw.y = cvt_pk_bf16(p[2], p[3]); pw.z = cvt_pk_bf16(p[4], p[5]); pw.w = cvt_pk_bf16(p[6], p[7]);
        const bf16x8 pb = __builtin_bit_cast(bf16x8, pw);
        if (__builtin_amdgcn_ballot_w64(corr != 1.0f) != 0ull) {
#pragma unroll
            for (int mt = 0; mt < 4; ++mt) O[hq][mt] *= corr; }
#pragma unroll
        for (int mt = 0; mt < 4; ++mt) O[hq][mt] = __builtin_amdgcn_mfma_f32_16x16x32_bf16(vf[mt], pb, O[hq][mt], 0, 0, 0);
    }
}
template <int NH, class InitF>
__device__ __forceinline__ void attn_core64(const LAS unsigned char* kbuf  , const LAS unsigned char* vbuf  , const InitF& initf  ,
                                            const bf16x8 (&bq)[NH][2], float (&m)[NH], float (&l)[NH], f32x4 (&O)[NH][4], int lane) {
    const int c = lane & 15, g = lane >> 4;
    bf16x8 pb[NH][2]; float corr[NH];
#pragma unroll
    for (int hq = 0; hq < NH; ++hq) {
        f32x4 sa[4];
#pragma unroll
        for (int t = 0; t < 4; ++t) sa[t] = initf(hq, t);
#pragma unroll
        for (int t = 0; t < 4; ++t) { const bf16x8 k0 = *(const LAS bf16x8*)(kbuf + (16 * t + c) * 144 + 16 * g), k1 = *(const LAS bf16x8*)(kbuf + (16 * t + c) * 144 + 16 * g + 64);
            sa[t] = __builtin_amdgcn_mfma_f32_16x16x32_bf16(k0, bq[hq][0], sa[t], 0, 0, 0); sa[t] = __builtin_amdgcn_mfma_f32_16x16x32_bf16(k1, bq[hq][1], sa[t], 0, 0, 0); }
        float mx = -3.0e38f;
#pragma unroll
        for (int t = 0; t < 4; ++t) mx = fmaxf(mx, fmaxf(fmaxf(sa[t][0], sa[t][1]), fmaxf(sa[t][2], sa[t][3])));
        mx = fmaxf(mx, xor_sw<16>(mx)); mx = max_x32(mx);
        const float mn = fmaxf(m[hq], mx); corr[hq] = __builtin_amdgcn_exp2f(m[hq] - mn); m[hq] = mn;
        float p[16], ps = 0.f;
#pragma unroll
        for (int i = 0; i < 16; ++i) { p[i] = __builtin_amdgcn_exp2f(sa[i >> 2][i & 3] - mn); ps += p[i]; }
        l[hq] = l[hq] * corr[hq] + ps;
        u32x4 pw0, pw1;
        pw0.x = cvt_pk_bf16(p[0], p[1]); pw0.y = cvt_pk_bf16(p[2], p[3]); pw0.z = cvt_pk_bf16(p[4], p[5]); pw0.w = cvt_pk_bf16(p[6], p[7]);
        pw1.x = cvt_pk_bf16(p[8], p[9]); pw1.y = cvt_pk_bf16(p[10], p[11]); pw1.z = cvt_pk_bf16(p[12], p[13]); pw1.w = cvt_pk_bf16(p[14], p[15]);
        pb[hq][0] = __builtin_bit_cast(bf16x8, pw0); pb[hq][1] = __builtin_bit_cast(bf16x8, pw1);
    }
#pragma unroll
    for (int hq = 0; hq < NH; ++hq) {
        if (__builtin_amdgcn_ballot_w64(corr[hq] != 1.0f) != 0ull) {
#pragma unroll
            for (int mt = 0; mt < 4; ++mt) O[hq][mt] *= corr[hq]; } }
#pragma unroll
    for (int sb = 0; sb < 2; ++sb) { bf16x8 vf[4];
        attn_vfrag(vbuf + 5120 * sb, vf, lane);
#pragma unroll
        for (int hq = 0; hq < NH; ++hq)
#pragma unroll
            for (int mt = 0; mt < 4; ++mt) O[hq][mt] = __builtin_amdgcn_mfma_f32_16x16x32_bf16(vf[mt], pb[hq][sb], O[hq][mt], 0, 0, 0);
    }
}
template <int NH, int P, class Desc, class BiasF>
__device__ __forceinline__ void attn_unit(const char* kp_base, const char* vp_base, const Desc& dsc, int ntile, const BiasF& biasf, const bf16x8 (&bq)[NH][2],
                                          float (&m)[NH], float (&l)[NH], f32x4 (&O)[NH][4], LAS unsigned char* vl  , int lane) {
    constexpr int U = (P % 2 == 0) ? P : 2 * P;
    bf16x8 kf[P][2][2], vr[P][4];
#pragma unroll
    for (int s = 0; s < P; ++s) attn_load(kp_base, vp_base, dsc(s), kf[s], vr[s], lane);
    attn_vwrite(vr[0], vl, lane);
#pragma unroll 1
    for (int t0 = 0; t0 < ntile; t0 += U) {
#pragma unroll
        for (int u = 0; u < U; ++u) {
            const int t = t0 + u;
            attn_vwrite(vr[(u + 1) % P], vl + ((u + 1) & 1) * 5120, lane);
            const TileD td = dsc(t);
            if (td.valid) { const LAS unsigned char* bp[NH];
#pragma unroll
                for (int hq = 0; hq < NH; ++hq) bp[hq] = biasf(td, hq);
                auto initf = [&](int hq, int hh) { return *(const LAS f32x4*)(bp[hq] + 64 * hh); };
                attn_core<NH>(kf[u % P], vl + (u & 1) * 5120, initf, bq, m, l, O, lane); }
            attn_load(kp_base, vp_base, dsc(t + P), kf[u % P], vr[u % P], lane);
        }
    }
}
constexpr int SH_K = 0, SH_V = 9216, SH_BUF = 19456;
__device__ __forceinline__ bf16x8 attn_sh_load(const char* kp_base, const char* vp_base, int kb, int tid, int r) {
    kb = kb < 0 ? 0 : (kb > SEQ - 64 ? SEQ - 64 : kb);
    const int row = 32 * r + ((tid & 255) >> 3), cc = tid & 7; const int kp = kb + row;
    return ld16((tid >> 8) ? vp_base : kp_base, (unsigned)kp * (unsigned)(ODD_IN * 2) + 16u * cc);
}
__device__ __forceinline__ void attn_sh_write(bf16x8 v, LAS unsigned char* buf, int tid, int r) {
    const int row = 32 * r + ((tid & 255) >> 3), cc = tid & 7;
    *(LAS bf16x8*)(buf + ((tid >> 8) ? SH_V + row * 160 : SH_K + row * 144) + cc * 16) = v;
}
template <int NH, int NQ, bool TABLE>
__device__ __forceinline__ void attn_stream(const char* kp_base, const char* vp_base, int kb0, int ntile  , float flim, const float (&fqp)[NQ], const LAS unsigned char* const (&tab)[NQ], const float (&slope2)[NH], const bf16x8 (&bq)[NH][2],
                                            float (&m)[NH], float (&l)[NH], f32x4 (&O)[NH][4], LAS unsigned char* sh, int tid, int lane, int jlo, int jhi  ) {
    const int g = lane >> 4;
    int iq[NQ];
#pragma unroll
    for (int q = 0; q < NQ; ++q) iq[q] = 4 * g - (int)fqp[q];
    bf16x8 ra[2];
#pragma unroll
    for (int r = 0; r < 2; ++r) { ra[r] = attn_sh_load(kp_base, vp_base, kb0, tid, r); }
#pragma unroll
    for (int r = 0; r < 2; ++r) attn_sh_write(ra[r], sh, tid, r);
#pragma unroll
    for (int r = 0; r < 2; ++r) ra[r] = attn_sh_load(kp_base, vp_base, kb0 + 64, tid, r);
    __syncthreads();
    for (int j = 0; j < ntile; ++j) {
        const int kb = kb0 + 64 * j; LAS unsigned char* buf = sh + (j & 1) * SH_BUF;
        if (j >= jlo && j <= jhi && !(kb + 63 < 0 || kb >= SEQ)) {
            if constexpr (TABLE) {
                const LAS unsigned char* bp[NQ];
#pragma unroll
                for (int q = 0; q < NQ; ++q) bp[q] = tab[q] + 4 * kb;
                auto initf = [&](int hq, int t) { return *(const LAS f32x4*)(bp[hq] + 64 * t); };
                attn_core64<NH>(buf + SH_K, buf + SH_V, initf, bq, m, l, O, lane);
            } else {
                const float fb = (float)(kb + iq[0]);
                if (__builtin_amdgcn_ballot_w64(!(fabsf(fb) <= flim && fabsf(fb + 51.f) <= flim)) == 0ull) {
                    auto initf = [&](int hq, int t) { f32x4 v;
#pragma unroll
                        for (int r = 0; r < 4; ++r) v[r] = -slope2[hq] * fabsf(fb + (float)(16 * t + r));
                        return v; };
                    attn_core64<NH>(buf + SH_K, buf + SH_V, initf, bq, m, l, O, lane);
                } else {
                    auto initf = [&](int hq, int t) { f32x4 v;
#pragma unroll
                        for (int r = 0; r < 4; ++r) { const float ad = fabsf(fb + (float)(16 * t + r)); v[r] = __builtin_fmaf(-slope2[hq], ad, (ad <= flim) ? 0.f : -3.0e38f); }
                        return v; };
                    attn_core64<NH>(buf + SH_K, buf + SH_V, initf, bq, m, l, O, lane);
                }
            }
        }
#pragma unroll
        for (int r = 0; r < 2; ++r) attn_sh_write(ra[r], sh + ((j + 1) & 1) * SH_BUF, tid, r);
#pragma unroll
        for (int r = 0; r < 2; ++r) ra[r] = attn_sh_load(kp_base, vp_base, kb0 + 64 * (j + 2), tid, r);
        __syncthreads();
    }
}
template <int NH>
__device__ __forceinline__ void attn_store(bf16_t* orow  , const int (&ocol)[NH], const float (&l)[NH], const float (&extra)[NH], const f32x4 (&O)[NH][4], int lane) {
    const int g = lane >> 4;
#pragma unroll
    for (int hq = 0; hq < NH; ++hq) { float lt = l[hq]; lt += xor_sw<16>(lt); lt = sum_x32(lt); lt += extra[hq];
        const float inv = 1.0f / lt;
#pragma unroll
        for (int mt = 0; mt < 4; ++mt) { u32x2 w;
            w.x = cvt_pk_bf16(O[hq][mt][0] * inv, O[hq][mt][1] * inv); w.y = cvt_pk_bf16(O[hq][mt][2] * inv, O[hq][mt][3] * inv);
            *(u32x2*)(orow + ocol[hq] + 16 * mt + 4 * g) = w; } }
}
__device__ __forceinline__ bf16x8 q_prescale(bf16x8 q) {
    const u32x4 w = __builtin_bit_cast(u32x4, q); float f[8]; unpack8(w, f);
#pragma unroll
    for (int i = 0; i < 8; ++i) f[i] *= 0.18033688011112042f;
    return __builtin_bit_cast(bf16x8, pack8(f));
}
__device__ __forceinline__ void ln_row16(float (&v)[16], const float* lng, const float* lnb, int lane, float (&o)[16]) {
    const float s = ((v[0] + v[1]) + (v[2] + v[3])) + ((v[4] + v[5]) + (v[6] + v[7])) + (((v[8] + v[9]) + (v[10] + v[11])) + ((v[12] + v[13]) + (v[14] + v[15])));
    const float mean = wave_sum(s) * (1.0f / D);
#pragma unroll
    for (int i = 0; i < 16; ++i) v[i] -= mean;
    const float s2 = ((v[0] * v[0] + v[1] * v[1]) + (v[2] * v[2] + v[3] * v[3])) + ((v[4] * v[4] + v[5] * v[5]) + (v[6] * v[6] + v[7] * v[7]))
                   + (((v[8] * v[8] + v[9] * v[9]) + (v[10] * v[10] + v[11] * v[11])) + ((v[12] * v[12] + v[13] * v[13]) + (v[14] * v[14] + v[15] * v[15])));
    const float rstd = 1.0f / sqrtf(wave_sum(s2) * (1.0f / D) + LN_EPS);
#pragma unroll
    for (int hf = 0; hf < 2; ++hf) { const int col = 512 * hf + 8 * lane;
        const f32x4 g0 = *(const f32x4*)(lng + col), g1 = *(const f32x4*)(lng + col + 4), b0 = *(const f32x4*)(lnb + col), b1 = *(const f32x4*)(lnb + col + 4);
#pragma unroll
        for (int i = 0; i < 4; ++i) { o[8 * hf + i] = v[8 * hf + i] * rstd * g0[i] + b0[i]; o[8 * hf + 4 + i] = v[8 * hf + 4 + i] * rstd * g1[i] + b1[i]; } }
}
__device__ __forceinline__ float q8_row16(const float (&o)[16], unsigned char* qrow, int lane) {
    float am = 0.f;
#pragma unroll
    for (int i = 0; i < 16; ++i) am = fmaxf(am, fabsf(o[i]));
    am = wave_max(am);
    const float qs = am > 0.f ? am * (1.0f / 127.0f) : 1.0f, qinv = 1.0f / qs;
#pragma unroll
    for (int hf = 0; hf < 2; ++hf) { u32x2 q; q.x = q8x4(o[8 * hf], o[8 * hf + 1], o[8 * hf + 2], o[8 * hf + 3], qinv); q.y = q8x4(o[8 * hf + 4], o[8 * hf + 5], o[8 * hf + 6], o[8 * hf + 7], qinv);
        *(u32x2*)(qrow + 512 * hf + 8 * lane) = q; }
    return qs;
}
__device__ __forceinline__ void store_bf16_row16(const float (&o)[16], bf16_t* row, int lane) {
#pragma unroll
    for (int hf = 0; hf < 2; ++hf) { const float (&oh)[8] = *(const float (*)[8])(o + 8 * hf); *(u32x4*)(row + 512 * hf + 8 * lane) = pack8(oh); }
}
struct Args { const float* in[17]; float* out; unsigned char* ws; int ph_lo, ph_hi; };

__global__ void __launch_bounds__(NWAVES * 64, 2) mk_fwd(Args args) {
    extern __shared__ __attribute__((aligned(16))) unsigned char lds_raw[];
    LAS unsigned char* lds = (LAS unsigned char*)lds_raw;
    const int G = gridDim.x, bx = blockIdx.x;
    const int wave_s = __builtin_amdgcn_readfirstlane(threadIdx.x >> 6);
    const int vcu = (G % 8 == 0) ? (bx % 8) * (G / 8) + bx / 8 : bx;
    const int NGW = G * NWAVES;
#define PHASE_IDS() int lane = lane_id(); asm volatile("" : "+v"(lane)); const int wave = wave_s, tid = wave_s * 64 + lane, gw = vcu * NWAVES + wave; (void)tid; (void)gw
    unsigned char* ws = args.ws;
    unsigned* ctl = (unsigned*)(ws + WS_CTL);
    bf16_t* XB = (bf16_t*)(ws + WS_XB); bf16_t* HB = (bf16_t*)(ws + WS_H); bf16_t* CAT = (bf16_t*)(ws + WS_CAT); bf16_t* YB = (bf16_t*)(ws + WS_Y);
    bf16_t* ACT = (bf16_t*)(ws + WS_ACT); bf16_t* YS = (bf16_t*)(ws + WS_YS); int* LIST = (int*)(ws + WS_LIST); i32x4* INFO = (i32x4*)(ws + WS_INFO);
    volatile LAS unsigned* MISC = (volatile LAS unsigned*)(lds + MISC_OFF);
    LAS int* CN = (LAS int*)(lds + TAB_OFF); LAS int* TB = (LAS int*)(lds + TAB_OFF + 128);
    if (threadIdx.x < 16) MISC[threadIdx.x] = 0u;
    __syncthreads();
#if MK_N_LAUNCHES == 1
    XcdBarrier bar = xcd_barrier_post(ctl + CW_BAR, MISC + 8);
#define GRID_BAR() xcd_barrier(bar, wave_s)
#else
#define GRID_BAR() do {} while (0)
#endif
#if MK_N_LAUNCHES == 1
#define IN(k) true
#define SEAM(k) GRID_BAR()
#else
    const int lo = args.ph_lo, hi = args.ph_hi;
#define IN(k) (lo <= (k) && (k) < hi)
#define SEAM(k) do {} while (0)
#endif

    for (int rep = 0; rep < NREP(7); ++rep) if (IN(0)) {
        PHASE_IDS();
        {
            LAS float* AM = (LAS float*)lds;
            int par = 0;
            for (int it = bx; it < 64 + 72; it += G, par ^= 1) {
                if (it < 64) { const int mi = it >> 5, nb = it & 31;
                    q8_cols_item<false, false>(args.in[1] + (size_t)mi * D * EVEN_IN, EVEN_IN, nb * 64, ws + WS_EVIN + (size_t)mi * EVEN_IN * 1024, (float*)(ws + WS_SBIN) + mi * EVEN_IN, AM, par, wave, lane); }
                else { const int r = it - 64, mi = r / 36, nb = r % 36;
                    q8_cols_item<false, false>(args.in[6] + (size_t)mi * D * ODD_IN, ODD_IN, nb * 64, ws + WS_ODIN + (size_t)mi * ODD_IN * 1024, (float*)(ws + WS_SBIN) + 16384 + mi * ODD_IN, AM, par, wave, lane); }
            }
            __syncthreads();
        }
        const float* ev_w_out = args.in[5]; const float* od_w_out = args.in[8];
        constexpr int I6 = 1024, I2 = 2 * 16 * 16, I3 = 2 * 8 * 16;
        constexpr int NITEMS = I6 + I2 + I3;
        for (int it = gw; it < NITEMS; it += NGW) {
            int r = __builtin_amdgcn_readfirstlane(it);
            if (r < I6) { fold_item(args.in[2], args.in[3], ev_w_out, (bf16_t*)(ws + WS_EVOUT), r, lane); continue; } r -= I6;
            if (r < I2) { const int mi = r / 256, q = r % 256; tconv_item<0>(od_w_out + (size_t)mi * D * D, D, (bf16_t*)(ws + WS_ODOUT) + (size_t)mi * D * D, q / 16, q % 16, lane); continue; } r -= I2;
            { const int mi = r / 128, q = r % 128; tconv_item<0>(ev_w_out + (size_t)mi * D * D, D, (bf16_t*)(ws + WS_EVOUT) + (size_t)mi * D * D, 8 + q / 16, q % 16, lane); }
        }
        const float* x = args.in[0];
        for (int t = gw; t < T; t += NGW) {
            float o[16];
#pragma unroll
            for (int hf = 0; hf < 2; ++hf) { const f32x4 a = *(const f32x4*)(x + (size_t)t * D + 512 * hf + 8 * lane), b = *(const f32x4*)(x + (size_t)t * D + 512 * hf + 8 * lane + 4);
#pragma unroll
                for (int i = 0; i < 4; ++i) { o[8 * hf + i] = a[i]; o[8 * hf + 4 + i] = b[i]; } }
            store_bf16_row16(o, XB + (size_t)t * D, lane);
            const float qs = q8_row16(o, ws + WS_XQ + (size_t)t * D, lane);
            if (lane == 0) ((float*)(ws + WS_SX))[t] = qs;
        }
    }
    SEAM(0);

    for (int layer = 0; layer < DEPTH; ++layer) {
        const int li = layer >> 1, odd = layer & 1, P = 1 + layer * PH_PER_LAYER;
        for (int rep = 0; rep < NREP(0); ++rep) if (IN(P + 0)) {
            pg8::DenseSched<true> S;
            if (odd) S.init(ws + WS_XQ, ws + WS_ODIN + (size_t)li * ODD_IN * 1024, T, ODD_IN, G, bx);
            else S.init(ws + WS_XQ, ws + WS_EVIN + (size_t)li * EVEN_IN * 1024, T, EVEN_IN, G, bx);
            pg8::EpiBf16<0> E{HB, odd ? ODD_IN : EVEN_IN, nullptr, nullptr, 0.f, (const float*)(ws + WS_SX), (const float*)(ws + WS_SBIN) + (odd ? 16384 + li * ODD_IN : li * EVEN_IN)};
            bool cv_fired = false;
            auto cv_hook = [&](int ui) {
                if (layer != 0 || cv_fired || (ui >= 0 && ui != ((bx >> 3) & 3))) return;
                cv_fired = true;
                LAS float* CAM = (LAS float*)(lds + RING_BYTES + 576 + 8192); const int lane_h = lane_id(); int par = 0;
#pragma unroll 1
                for (int r = bx; r < 1536; r += G, par ^= 1) {
                    if (r < 1024) { const int mi = r >> 5, nb = ((r & 31) + 8 * ((r >> 6) & 3)) & 31;
                        q8_cols_item<true, false>(args.in[11] + (size_t)mi * D * 2048, 2048, nb * 64, ws + WS_WGU + (size_t)mi * 2048 * 1024, (float*)(ws + WS_SB) + (size_t)mi * 2048, CAM, par, wave_s, lane_h); }
                    else { const int r2 = r - 1024, mi = r2 >> 4, nb = ((r2 & 15) + 8 * ((r2 >> 6) & 1)) & 15;
                        q8_cols_item<false, true>(args.in[13] + (size_t)mi * D * D, D, nb * 64, ws + WS_WDN + (size_t)mi * D * 1024, (float*)(ws + WS_SBD) + (size_t)mi * D, CAM, par, wave_s, lane_h); } }
                __syncthreads();
            };
            pg8::gemm_phase<1>(lds, S, E, wave_s, lds + RING_BYTES + 576, cv_hook);
        }
        SEAM(P + 0);
        for (int rep = 0; rep < NREP(1); ++rep) if (IN(P + 1)) {
            PHASE_IDS();
            if (!odd) {
                const float* conv_w = args.in[4] + (size_t)li * 3 * 512;
                for (int task = gw; task < 2048; task += NGW) {
                    const int run = task >> 1, kind = task & 1, b = run >> 6, t0 = (run & 63) * 32;
                    const bf16_t* hb = HB + (size_t)b * SEQ * EVEN_IN; bf16_t* cb = CAT + (size_t)b * SEQ * D;
                    if (kind == 0) {
                        const int ch0 = 8 * lane, half = 1 << (lane >> 4);
                        const bf16_t* base = hb + ch0;
                        float sum[8];
#pragma unroll
                        for (int i = 0; i < 8; ++i) sum[i] = 0.f;
                        {   u32x4 r0[16];
#pragma unroll
                            for (int j = 0; j < 16; ++j) { int p = t0 + j - 8; p = p < 0 ? 0 : (p > SEQ - 1 ? SEQ - 1 : p); r0[j] = *(const u32x4*)(base + (size_t)p * EVEN_IN); }
                            __builtin_amdgcn_sched_barrier(0);
#pragma unroll
                            for (int j = 0; j < 16; ++j) { const int dp = j - 8, p = t0 + dp; const float fl = (dp >= -half && dp < half && p >= 0 && p < SEQ) ? 1.f : 0.f;
                                float f[8]; unpack8(r0[j], f);
#pragma unroll
                                for (int i = 0; i < 8; ++i) sum[i] += fl * f[i]; } }
                        for (int tc = t0; tc < t0 + 32; tc += 8) {
                            u32x4 ru[8], ra[8], rb[8];
#pragma unroll
                            for (int j = 0; j < 8; ++j) { const int t = tc + j, pa = (t + half < SEQ) ? t + half : SEQ - 1, pb = (t - half >= 0) ? t - half : 0;
                                ru[j] = *(const u32x4*)(base + (size_t)t * EVEN_IN); ra[j] = *(const u32x4*)(base + (size_t)pa * EVEN_IN); rb[j] = *(const u32x4*)(base + (size_t)pb * EVEN_IN); }
                            __builtin_amdgcn_sched_barrier(0);
#pragma unroll
                            for (int j = 0; j < 8; ++j) { const int t = tc + j;
                                const int wlo = (t - half) > 0 ? (t - half) : 0, whi = (t + half) < SEQ ? (t + half) : SEQ;
                                const float rc = 1.0f / (float)(whi - wlo), fa = (t + half < SEQ) ? 1.f : 0.f, fb = (t - half >= 0) ? 1.f : 0.f;
                                float u[8], o[8], f[8]; unpack8(ru[j], u);
#pragma unroll
                                for (int i = 0; i < 8; ++i) o[i] = sum[i] * rc - u[i];
                                *(u32x4*)(cb + (size_t)t * D + ch0) = pack8(o);
                                unpack8(ra[j], f);
#pragma unroll
                                for (int i = 0; i < 8; ++i) sum[i] += fa * f[i];
                                unpack8(rb[j], f);
#pragma unroll
                                for (int i = 0; i < 8; ++i) sum[i] -= fb * f[i]; }
                        }
                    } else {
                        const int ch0 = 8 * lane;
                        float w0[8], w1[8], w2[8];
                        { const f32x4 a0 = *(const f32x4*)(conv_w + ch0), a1 = *(const f32x4*)(conv_w + ch0 + 4), b0 = *(const f32x4*)(conv_w + 512 + ch0), b1 = *(const f32x4*)(conv_w + 512 + ch0 + 4),
                                      c0 = *(const f32x4*)(conv_w + 1024 + ch0), c1 = *(const f32x4*)(conv_w + 1024 + ch0 + 4);
#pragma unroll
                          for (int i = 0; i < 4; ++i) { w0[i] = a0[i]; w0[4 + i] = a1[i]; w1[i] = b0[i]; w1[4 + i] = b1[i]; w2[i] = c0[i]; w2[4 + i] = c1[i]; } }
                        const bf16_t* pb = hb + 512 + ch0; const bf16_t* pc = hb + 1024 + ch0; const bf16_t* pv = hb + 1536 + ch0;
                        float up[8], uc[8], un[8];
#pragma unroll
                        for (int i = 0; i < 8; ++i) up[i] = 0.f;
                        if (t0 > 0) { float c[8], v[8]; unpack8(*(const u32x4*)(pc + (size_t)(t0 - 1) * EVEN_IN), c); unpack8(*(const u32x4*)(pv + (size_t)(t0 - 1) * EVEN_IN), v);
#pragma unroll
                            for (int i = 0; i < 8; ++i) up[i] = c[i] * v[i]; }
                        { float c[8], v[8]; unpack8(*(const u32x4*)(pc + (size_t)t0 * EVEN_IN), c); unpack8(*(const u32x4*)(pv + (size_t)t0 * EVEN_IN), v);
#pragma unroll
                            for (int i = 0; i < 8; ++i) uc[i] = c[i] * v[i]; }
                        for (int tc = t0; tc < t0 + 32; tc += 8) {
                            u32x4 rc_[8], rv_[8], rg_[8];
#pragma unroll
                            for (int j = 0; j < 8; ++j) { const int t = tc + j, pn = (t + 1 < SEQ) ? t + 1 : SEQ - 1;
                                rc_[j] = *(const u32x4*)(pc + (size_t)pn * EVEN_IN); rv_[j] = *(const u32x4*)(pv + (size_t)pn * EVEN_IN); rg_[j] = *(const u32x4*)(pb + (size_t)t * EVEN_IN); }
                            __builtin_amdgcn_sched_barrier(0);
#pragma unroll
                            for (int j = 0; j < 8; ++j) { const int t = tc + j; const float fn = (t + 1 < SEQ) ? 1.f : 0.f;
                                float c[8], v[8], bg[8], o[8]; unpack8(rc_[j], c); unpack8(rv_[j], v); unpack8(rg_[j], bg);
#pragma unroll
                                for (int i = 0; i < 8; ++i) { un[i] = fn * (c[i] * v[i]); o[i] = bg[i] * (up[i] * w0[i] + uc[i] * w1[i] + un[i] * w2[i]); up[i] = uc[i]; uc[i] = un[i]; }
                                *(u32x4*)(cb + (size_t)t * D + 512 + ch0) = pack8(o); }
                        }
                    }
                }
            } else {
                const float* sinkp = args.in[7] + li * 8;
                LAS unsigned char* vl = lds + wave * 10240;
                LAS unsigned char* sh = lds + 81920;
                const int c = lane & 15, g = lane >> 4;
                constexpr float LOG2E = 1.4426950408889634f;
                const int cv_first = layer, cv_n = (layer == 1) ? 2 * 1536 : 1536;
                int cv_it = bx, cv_par = 0, cv_done = 0;
                const int cv_mine = (cv_n - bx + G - 1) / G;
                const int n_bu = (2048 - bx + G - 1) / G;
                LAS float* CAM = (LAS float*)(lds + 120832);
                LAS float* TAB16 = (LAS float*)(lds + 124928);
                LAS float* TAB1 = (LAS float*)(lds + 131136);
                LAS float* TAB4 = (LAS float*)(lds + 141504);
                {   int hh = (bx >> 3) & 7; asm volatile("" : "+s"(hh));
                    const float sl2 = exp2f(-(float)(hh + 1)) * LOG2E;
                    for (int i = tid; i < 4 * 648; i += NWAVES * 64) { const int sft = i / 648, k = i - sft * 648; const float ad = fabsf((float)(k - sft - 320)); TAB1[i] = ad <= 64.f ? -sl2 * ad : -3.0e38f; }
                    for (int i = tid; i < 4 * 260; i += NWAVES * 64) { const int sft = i / 260, k = i - sft * 260; const float a1 = fabsf((float)(k - sft - 128));
                        TAB4[i] = 4.f * a1 <= 256.f ? -sl2 * 4.f * a1 : -3.0e38f; TAB16[i] = 16.f * a1 <= 1024.f ? -sl2 * 16.f * a1 : -3.0e38f; }
                    __syncthreads(); }
                int bu_idx = 0;
                for (int bu = bx; bu < 2048; bu += G, ++bu_idx) {
                    {   const int target = (bu_idx >= ((bx >> 3) % n_bu)) ? cv_mine : 0;
                        for (; cv_done < target; ++cv_done, cv_it += G, cv_par ^= 1) {
                            const int lyr = cv_first + cv_it / 1536, r = cv_it % 1536;
                            if (r < 1024) { const int mi = lyr * 32 + (r >> 5), nb = ((r & 31) + 8 * ((r >> 6) & 3)) & 31;
                                q8_cols_item<true, false>(args.in[11] + (size_t)mi * D * 2048, 2048, nb * 64, ws + WS_WGU + (size_t)mi * 2048 * 1024, (float*)(ws + WS_SB) + (size_t)mi * 2048, CAM, cv_par, wave, lane); }
                            else { const int r2 = r - 1024, mi = lyr * 32 + (r2 >> 4), nb = ((r2 & 15) + 8 * ((r2 >> 6) & 1)) & 15;
                                q8_cols_item<false, true>(args.in[13] + (size_t)mi * D * D, D, nb * 64, ws + WS_WDN + (size_t)mi * D * 1024, (float*)(ws + WS_SBD) + (size_t)mi * D, CAM, cv_par, wave, lane); }
                        }
                    }
                    int c_u = lane & 15, g_u = lane >> 4; asm volatile("" : "+v"(c_u), "+v"(g_u));
                    const int c = c_u, g = g_u;
                    if (bu < 1024) {
                        const int b = bu >> 6, h = (bu >> 3) & 7, ib = bu & 7;
                        const bf16_t* hb = HB + (size_t)b * SEQ * ODD_IN;
                        const char* kpb = (const char*)(hb + 512 + h * 64); const char* vpb = (const char*)(hb + 1024 + h * 64);
                        const float slope2[1] = {exp2f(-(float)(h + 1)) * LOG2E};
                        bf16x8 bq[2][2]; float m[2], l[2], fq2[2]; f32x4 O[2][4];
                        auto per_wave_part = [&](auto RR) { constexpr int rr = decltype(RR)::value;
                            const int rho = wave + 8 * rr, q0 = rho + 256 * ib, qp = q0 + 16 * c;
                            bf16x8 bq1[1][2];
                            { const bf16_t* qr = hb + (size_t)qp * ODD_IN + h * 64 + 8 * g; bq1[0][0] = q_prescale(*(const bf16x8*)qr); bq1[0][1] = q_prescale(*(const bf16x8*)(qr + 32)); }
                            float m1[1] = {-1e30f}, l1[1] = {0.f}; f32x4 O1[1][4];
#pragma unroll
                            for (int mt = 0; mt < 4; ++mt) O1[0][mt] = (f32x4){0.f, 0.f, 0.f, 0.f};
                            auto dsc = [&](int tl) { TileD t; t.kb = rho + 512 * tl; t.d = 16; t.flim = 1024.f;
                                t.valid = (tl < 4) && (512 * tl - 256 * ib - 240 <= 1024) && (256 * ib - 512 * tl - 496 <= 1024); return t; };
                            const LAS unsigned char* t16 = (const LAS unsigned char*)TAB16 + 1040 * (c & 3) + 4 * (128 + (c & 3) - 16 * ib - c + 4 * g);
                            auto bias16 = [&](const TileD& t, int) { return t16 + ((t.kb - rho) >> 2); };
                            attn_unit<1, 2>(kpb, vpb, dsc, 4, bias16, bq1, m1, l1, O1, vl, lane);
                            bq[rr][0] = bq1[0][0]; bq[rr][1] = bq1[0][1]; m[rr] = m1[0]; l[rr] = l1[0]; fq2[rr] = (float)qp;
#pragma unroll
                            for (int mt = 0; mt < 4; ++mt) O[rr][mt] = O1[0][mt];
                        };
                        per_wave_part(std::integral_constant<int, 0>{}); per_wave_part(std::integral_constant<int, 1>{});
                        const float slope22[2] = {slope2[0], slope2[0]};
                        {
                            const int kb4 = 256 * (ib - 1) + (wave & 3);
                            auto dsc4 = [&](int tl) { TileD t; t.kb = kb4 + 128 * tl; t.d = 4; t.flim = 256.f; t.valid = (tl < 6) && !(t.kb < 0 || t.kb >= SEQ); return t; };
                            const LAS unsigned char* t4[2];
#pragma unroll
                            for (int q = 0; q < 2; ++q) { const int s4 = ((wave >> 2) + 2 * q) & 3; t4[q] = (const LAS unsigned char*)TAB4 + 1040 * s4 + 4 * (128 + s4 - 64 - (wave >> 2) - 2 * q + 4 * g - 4 * c) - kb4; }
                            auto bias4 = [&](const TileD& t, int q) { return (q == 0 ? t4[0] : t4[1]) + t.kb; };
                            attn_unit<2, 2>(kpb, vpb, dsc4, 6, bias4, bq, m, l, O, vl, lane);
                        }
                        bf16x8 qraw[2][2];
#pragma unroll
                        for (int sl = 0; sl < 2; ++sl) { const bf16_t* qr = hb + (size_t)(256 * ib + 32 * wave + 16 * sl + c) * ODD_IN + h * 64 + 8 * g; qraw[sl][0] = *(const bf16x8*)qr; qraw[sl][1] = *(const bf16x8*)(qr + 32); }
                        __syncthreads();
                        {   LAS float* PARK = (LAS float*)lds;
#pragma unroll
                            for (int q = 0; q < 2; ++q) { float lt = l[q]; lt += xor_sw<16>(lt); lt = sum_x32(lt);
                                const int pp = wave + 8 * q + 16 * c;
#pragma unroll
                                for (int mt = 0; mt < 4; ++mt) *(LAS f32x4*)(PARK + pp * 68 + 4 * ((4 * mt + g) ^ c)) = O[q][mt];
                                if (g == 0) { PARK[pp * 68 + 64] = m[q]; PARK[pp * 68 + 65] = lt; } }
                            const LAS unsigned char* t1[2];
#pragma unroll
                            for (int sl = 0; sl < 2; ++sl) { const int qp = 256 * ib + 32 * wave + 16 * sl + c;
                                bq[sl][0] = q_prescale(qraw[sl][0]); bq[sl][1] = q_prescale(qraw[sl][1]);
                                m[sl] = -1e30f; l[sl] = 0.f; fq2[sl] = (float)qp;
#pragma unroll
                                for (int mt = 0; mt < 4; ++mt) O[sl][mt] = (f32x4){0.f, 0.f, 0.f, 0.f};
                                t1[sl] = (const LAS unsigned char*)TAB1 + 2592 * (c & 3) + 4 * (320 + (c & 3) + 4 * g - qp); }
                            attn_stream<2, 2, true>(kpb, vpb, 256 * ib - 64, 6, 64.f, fq2, t1, slope22, bq, m, l, O, sh, tid, lane, wave >> 1, (wave >> 1) + 2);
#pragma unroll
                            for (int sl = 0; sl < 2; ++sl) { const int pp = 32 * wave + 16 * sl + c, sw = (2 * wave + sl) & 15;
                                float lt = l[sl]; lt += xor_sw<16>(lt); lt = sum_x32(lt);
                                const float mc = PARK[pp * 68 + 64], lc = PARK[pp * 68 + 65];
                                const float mn = fmaxf(m[sl], mc), fa = __builtin_amdgcn_exp2f(m[sl] - mn), fb = __builtin_amdgcn_exp2f(mc - mn);
                                const float inv = 1.0f / (lt * fa + lc * fb);
                                bf16_t* orow = CAT + (size_t)(b * SEQ + 256 * ib + pp) * D + h * 64;
#pragma unroll
                                for (int mt = 0; mt < 4; ++mt) { const f32x4 oc = *(const LAS f32x4*)(PARK + pp * 68 + 4 * ((4 * mt + g) ^ sw)); const f32x4 v = (O[sl][mt] * fa + oc * fb) * inv;
                                    u32x2 w; w.x = cvt_pk_bf16(v[0], v[1]); w.y = cvt_pk_bf16(v[2], v[3]); *(u32x2*)(orow + 16 * mt + 4 * g) = w; } }
                        }
                        __syncthreads();
                    } else {
                        const int ud = bu - 1024, b = ud >> 6, kvh = (ud >> 5) & 1, qb = ud & 31;
                        const bf16_t* hb = HB + (size_t)b * SEQ * ODD_IN;
                        const int hp = wave & 1, q0 = 64 * qb + 16 * (wave >> 1), qp = q0 + c;
                        bf16x8 bq[2][2]; float m[2], l[2], slope2[2]; f32x4 O[2][4];
#pragma unroll
                        for (int j = 0; j < 2; ++j) { const int hq = 4 * kvh + 2 * hp + j; const bf16_t* qr = hb + (size_t)qp * ODD_IN + 1536 + hq * 64 + 8 * g;
                            bq[j][0] = q_prescale(*(const bf16x8*)qr); bq[j][1] = q_prescale(*(const bf16x8*)(qr + 32)); m[j] = -1e30f; l[j] = 0.f; slope2[j] = exp2f(-(float)(hq + 1)) * LOG2E;
#pragma unroll
                            for (int mt = 0; mt < 4; ++mt) O[j][mt] = (f32x4){0.f, 0.f, 0.f, 0.f}; }
                        const char* kpb = (const char*)(hb + 2048 + kvh * 64); const char* vpb = (const char*)(hb + 2176 + kvh * 64);
                        { const float fq1[1] = {(float)qp}; const LAS unsigned char* const notab[1] = {nullptr}; attn_stream<2, 1, false>(kpb, vpb, 64 * qb - 128, 5, 128.f, fq1, notab, slope2, bq, m, l, O, sh, tid, lane, 0, 4); }
                        int ocol[2]; float extra[2];
#pragma unroll
                        for (int j = 0; j < 2; ++j) { const int hq = 4 * kvh + 2 * hp + j; ocol[j] = 512 + hq * 64; extra[j] = __builtin_amdgcn_exp2f(sinkp[hq] * LOG2E - m[j]); }
                        attn_store<2>(CAT + (size_t)(b * SEQ + qp) * D, ocol, l, extra, O, lane);
                    }
                }
                __syncthreads();
            }
        }
        SEAM(P + 1);
        for (int rep = 0; rep < NREP(2); ++rep) if (IN(P + 2)) {
            pg8::DenseSched<false> S; S.init(CAT, odd ? (bf16_t*)(ws + WS_ODOUT) + (size_t)li * D * D : (bf16_t*)(ws + WS_EVOUT) + (size_t)li * D * D, T, D, G, bx);
            pg8::EpiBf16<1> E{YB, D, XB, nullptr, ALPHA, nullptr, nullptr};
            pg8::gemm_phase<0>(lds, S, E, wave_s, lds + RING_BYTES + 576);
        }
        SEAM(P + 2);
        if (IN(P + 3)) {
            PHASE_IDS();
            constexpr int XS = 1028;
            LAS float* XL = (LAS float*)lds;
            LAS float* PART = (LAS float*)(lds + 65792);
            LAS float* LOG = (LAS float*)(lds + 82176);
            LAS int* LCNT = (LAS int*)(lds + 84224);
            LAS int* GBASE = (LAS int*)(lds + 84352);
            LAS i32x4* REC = (LAS i32x4*)(lds + 84480);
            LAS float* TSC = (LAS float*)(lds + 122880);
            LAS float* TOP = (LAS float*)(lds + 124928);
            const float* lng = args.in[15] + (size_t)(layer * 2 + 0) * D; const float* lnb = args.in[16] + (size_t)(layer * 2 + 0) * D;
            const float* rw = args.in[9] + (size_t)layer * D * NEXP; const float* rb = args.in[10] + layer * NEXP;
            if (tid < 32) LCNT[tid] = 0;
            __syncthreads();
            const int tk = lane & 15, kq = lane >> 4;
            auto split8 = [](const float (&f)[8], bf16x8& hi, bf16x8& lo) { const u32x4 h = pack8(f); float fh[8], fl[8]; unpack8(h, fh);
#pragma unroll
                for (int i = 0; i < 8; ++i) fl[i] = f[i] - fh[i];
                hi = __builtin_bit_cast(bf16x8, h); lo = __builtin_bit_cast(bf16x8, pack8(fl)); };
            bf16x8 rwh[4][2], rwl[4][2];
#pragma unroll
            for (int ks = 0; ks < 4; ++ks)
#pragma unroll
                for (int tile = 0; tile < 2; ++tile) { float f[8];
#pragma unroll
                    for (int j = 0; j < 8; ++j) f[j] = rw[(size_t)(128 * wave + 32 * ks + 8 * kq + j) * NEXP + 16 * tile + tk];
                    split8(f, rwh[ks][tile], rwl[ks][tile]); }
            int nbatch = 0;
            for (int rep = 0; rep < NREP(3); ++rep) {
            const bool dummy = rep + 1 < NREP(3);
            bf16_t* XBo = dummy ? CAT : XB; unsigned char* XQo = dummy ? (unsigned char*)HB : ws + WS_XQ;
            if (rep > 0) { __syncthreads(); if (tid < 32) LCNT[tid] = 0; __syncthreads(); }
            nbatch = 0;
            u32x4 yp[2][2];
            {   const int b0 = bx < T / 16 ? bx : 0;
#pragma unroll
                for (int ii = 0; ii < 2; ++ii) { const size_t t = (size_t)b0 * 16 + wave * 2 + ii; yp[ii][0] = *(const u32x4*)(YB + t * D + 8 * lane); yp[ii][1] = *(const u32x4*)(YB + t * D + 512 + 8 * lane); } }
            for (int bi = bx; bi < T / 16; bi += G, ++nbatch) {
                u32x4 yc[2][2];
#pragma unroll
                for (int ii = 0; ii < 2; ++ii) { yc[ii][0] = yp[ii][0]; yc[ii][1] = yp[ii][1]; }
                {   const int bn = (bi + G < T / 16) ? bi + G : bi;
#pragma unroll
                    for (int ii = 0; ii < 2; ++ii) { const size_t t = (size_t)bn * 16 + wave * 2 + ii; yp[ii][0] = *(const u32x4*)(YB + t * D + 8 * lane); yp[ii][1] = *(const u32x4*)(YB + t * D + 512 + 8 * lane); } }
#pragma unroll
                for (int ii = 0; ii < 2; ++ii) {
                    const int tl = wave * 2 + ii, t = bi * 16 + tl;
                    float v[16], o[16];
#pragma unroll
                    for (int hf = 0; hf < 2; ++hf) { float f[8]; unpack8(yc[ii][hf], f);
#pragma unroll
                        for (int i = 0; i < 8; ++i) v[8 * hf + i] = f[i]; }
                    ln_row16(v, lng, lnb, lane, o);
#pragma unroll
                    for (int hf = 0; hf < 2; ++hf) { const int col = 512 * hf + 8 * lane;
                        *(LAS f32x4*)(XL + tl * XS + col) = (f32x4){o[8 * hf], o[8 * hf + 1], o[8 * hf + 2], o[8 * hf + 3]}; *(LAS f32x4*)(XL + tl * XS + col + 4) = (f32x4){o[8 * hf + 4], o[8 * hf + 5], o[8 * hf + 6], o[8 * hf + 7]}; }
                    const float qs = q8_row16(o, XQo + (size_t)t * D, lane);
                    if (lane == 0) TSC[nbatch * 16 + tl] = qs;
                }
                __syncthreads();
                {
                    f32x4 a0 = (f32x4){0.f, 0.f, 0.f, 0.f}, a1 = (f32x4){0.f, 0.f, 0.f, 0.f};
#pragma unroll
                    for (int ks = 0; ks < 4; ++ks) { const LAS float* xp = XL + tk * XS + 128 * wave + 32 * ks + 8 * kq; const f32x4 p = *(const LAS f32x4*)xp, q = *(const LAS f32x4*)(xp + 4);
                        const float f[8] = {p[0], p[1], p[2], p[3], q[0], q[1], q[2], q[3]}; bf16x8 xh, xl; split8(f, xh, xl);
                        a0 = __builtin_amdgcn_mfma_f32_16x16x32_bf16(xh, rwh[ks][0], a0, 0, 0, 0); a1 = __builtin_amdgcn_mfma_f32_16x16x32_bf16(xh, rwh[ks][1], a1, 0, 0, 0);
                        a0 = __builtin_amdgcn_mfma_f32_16x16x32_bf16(xh, rwl[ks][0], a0, 0, 0, 0); a1 = __builtin_amdgcn_mfma_f32_16x16x32_bf16(xh, rwl[ks][1], a1, 0, 0, 0);
                        a0 = __builtin_amdgcn_mfma_f32_16x16x32_bf16(xl, rwh[ks][0], a0, 0, 0, 0); a1 = __builtin_amdgcn_mfma_f32_16x16x32_bf16(xl, rwh[ks][1], a1, 0, 0, 0); }
#pragma unroll
                    for (int r = 0; r < 4; ++r) { PART[(wave * 16 + 4 * kq + r) * 32 + tk] = a0[r]; PART[(wave * 16 + 4 * kq + r) * 32 + 16 + tk] = a1[r]; }
                }
                __syncthreads();
                {   const int tq = tid >> 5, e = tid & 31; float s = rb[e];
#pragma unroll
                    for (int w = 0; w < 8; ++w) s += PART[(w * 16 + tq) * 32 + e];
                    const unsigned ub = __float_as_uint(s), key = (((ub >> 31) ? ~ub : (ub | 0x80000000u)) & ~31u) | (unsigned)(31 - e);
                    ((LAS unsigned*)LOG)[tq * 32 + e] = key;
                    asm volatile("s_waitcnt lgkmcnt(0)" ::: "memory");
                    int rank = 0;
#pragma unroll
                    for (int q = 0; q < 8; ++q) { const u32x4 t4 = *(const LAS u32x4*)((LAS unsigned*)LOG + tq * 32 + 4 * q);
#pragma unroll
                        for (int r = 0; r < 4; ++r) rank += (t4[r] > key) ? 1 : 0; }
                    if (rank < 4) TOP[tq * 4 + rank] = s;
                    asm volatile("s_waitcnt lgkmcnt(0)" ::: "memory");
                    if (rank < 4) {
                        const f32x4 tv = *(const LAS f32x4*)(TOP + tq * 4);
                        const float es = 1.0f + __expf(tv[1] - tv[0]) + __expf(tv[2] - tv[0]) + __expf(tv[3] - tv[0]);
                        const float wgt = __expf(s - tv[0]) * (1.0f / es);
                        const int lp = atomicAdd((int*)(LCNT + e), 1);
                        REC[(nbatch * 16 + tq) * 4 + rank] = (i32x4){e, lp, __float_as_int(wgt), bi * 16 + tq}; }
                }
            }
            }
            __syncthreads();
            if (tid < 32) { const int cc = LCNT[tid]; GBASE[tid] = cc ? (int)atomicAdd(ctl + CW_CNT + layer * 64 + tid, (unsigned)cc) : 0; }
            __syncthreads();
            for (int a = tid; a < nbatch * 64; a += NWAVES * 64) { const i32x4 r = REC[a]; const int pos = GBASE[r.x] + r.y;
                LIST[(size_t)r.x * T + pos] = r.w; ((float*)(ws + WS_SXS))[(size_t)r.x * T + pos] = TSC[a >> 2]; INFO[(size_t)r.w * 4 + (a & 3)] = (i32x4){r.x, pos, r.z, 0}; }
            __syncthreads();
        }
        SEAM(P + 3);
        if (IN(P + 4) || IN(P + 5) || IN(P + 6)) {
            PHASE_IDS();
            if (tid < 32) CN[tid] = (int)__hip_atomic_load(ctl + CW_CNT + layer * 64 + tid, __ATOMIC_RELAXED, __HIP_MEMORY_SCOPE_AGENT);
            __syncthreads();
            if (tid == 0) { int s = 0; for (int e = 0; e < 32; ++e) { TB[e] = s; s += (CN[e] + 255) >> 8; } TB[32] = s; }
            __syncthreads();
        }
        for (int rep = 0; rep < NREP(4); ++rep) if (IN(P + 4)) {
            pg8::MoeSched<true, true> S; S.A = (const char*)(ws + WS_XQ); S.Bt = (const char*)(ws + WS_WGU) + (size_t)layer * NEXP * 2048 * D; S.list = LIST; S.tb = TB; S.cn = CN; S.NN = 8; S.total = TB[32] * 8; S.G = G; S.vcu = vcu;
            pg8::EpiSwiGLU E{ACT, args.in[12] + (size_t)layer * NEXP * 2048, (const float*)(ws + WS_SB) + (size_t)layer * NEXP * 2048, (const float*)(ws + WS_SXS)};
            pg8::gemm_phase<1>(lds, S, E, wave_s, lds + RING_BYTES + 576);
        }
        SEAM(P + 4);
        for (int rep = 0; rep < NREP(5); ++rep) if (IN(P + 5)) {
            pg8::MoeSched<false, true> S; S.A = (const char*)ACT; S.Bt = (const char*)(ws + WS_WDN) + (size_t)layer * NEXP * D * 1024; S.list = LIST; S.tb = TB; S.cn = CN; S.NN = 4; S.total = TB[32] * 4; S.G = G; S.vcu = vcu;
            pg8::EpiBf16<3> E{YS, D, nullptr, args.in[14] + (size_t)layer * NEXP * D, 0.f, nullptr, (const float*)(ws + WS_SBD) + (size_t)layer * NEXP * D};
            pg8::gemm_phase<2>(lds, S, E, wave_s, lds + RING_BYTES + 576);
        }
        SEAM(P + 5);
        if (IN(P + 6)) {
            PHASE_IDS();
            const float* lng = args.in[15] + (size_t)(layer * 2 + 1) * D; const float* lnb = args.in[16] + (size_t)(layer * 2 + 1) * D;
            const float* lng1 = args.in[15] + (size_t)(layer * 2 + 0) * D; const float* lnb1 = args.in[16] + (size_t)(layer * 2 + 0) * D;
            for (int rep = 0; rep < NREP(6); ++rep) {
            const bool dummy = rep + 1 < NREP(6);
            bf16_t* XBo = dummy ? YB : XB; unsigned char* XQo = dummy ? (unsigned char*)CAT : ws + WS_XQ; float* SXo = dummy ? (float*)ACT : (float*)(ws + WS_SX); float* OUTo = dummy ? (float*)HB : args.out;
            auto tok_of = [&](int t0, int j) { return (j == 0 || t0 + NGW >= T) ? t0 : t0 + NGW; };
            auto load_raw = [&](int t0) { return INFO[(size_t)tok_of(t0, (lane >> 2) & 1) * 4 + (lane & 3)]; };
            auto unpack_raw = [&](const i32x4& raw, int (&e)[2][4], int (&p)[2][4], float (&gq)[2][4]) {
#pragma unroll
                for (int j = 0; j < 2; ++j)
#pragma unroll
                    for (int k = 0; k < 4; ++k) { e[j][k] = __builtin_amdgcn_readlane(raw.x, 4 * j + k); p[j][k] = __builtin_amdgcn_readlane(raw.y, 4 * j + k);
                        gq[j][k] = __int_as_float(__builtin_amdgcn_readlane(raw.z, 4 * j + k)) * (1.0f / 16.0f); } };
            auto load_rows = [&](int t0, const int (&e)[2][4], const int (&p)[2][4], u32x4 (&xr)[2][2], u32x2 (&yr)[2][4][2]) {
#pragma unroll
                for (int j = 0; j < 2; ++j) { const int t = tok_of(t0, j);
                    xr[j][0] = *(const u32x4*)(YB + (size_t)t * D + 8 * lane); xr[j][1] = *(const u32x4*)(YB + (size_t)t * D + 512 + 8 * lane);
#pragma unroll
                    for (int k = 0; k < 4; ++k) { const unsigned char* yp = (const unsigned char*)YS + ((size_t)TB[e[j][k]] * 256 + p[j][k]) * D;
                        yr[j][k][0] = *(const u32x2*)(yp + 8 * lane); yr[j][k][1] = *(const u32x2*)(yp + 512 + 8 * lane); } } };
            u32x4 xr[2][2], xrn[2][2]; u32x2 yr[2][4][2], yrn[2][4][2]; float gt[2][4];
            i32x4 raw = load_raw(gw);
            { int e0[2][4], p0[2][4]; unpack_raw(raw, e0, p0, gt); load_rows(gw, e0, p0, xr, yr); }
            raw = load_raw((gw + 2 * NGW < T) ? gw + 2 * NGW : gw);
            for (int t0 = gw; t0 < T; t0 += 2 * NGW) {
                int tt[2]; tt[0] = t0; tt[1] = tok_of(t0, 1);
                const int t1 = (t0 + 2 * NGW < T) ? t0 + 2 * NGW : t0, t2 = (t1 + 2 * NGW < T) ? t1 + 2 * NGW : t1;
                int en[2][4], pn[2][4]; float gn[2][4];
                unpack_raw(raw, en, pn, gn);
                load_rows(t1, en, pn, xrn, yrn);
                raw = load_raw(t2);
                __builtin_amdgcn_sched_barrier(0);
                float o[2][16];
#pragma unroll
                for (int j = 0; j < 2; ++j) {
                    float v[16], x1[16];
#pragma unroll
                    for (int hf = 0; hf < 2; ++hf) { float f[8]; unpack8(xr[j][hf], f);
#pragma unroll
                        for (int i = 0; i < 8; ++i) v[8 * hf + i] = f[i]; }
                    ln_row16(v, lng1, lnb1, lane, x1);
#pragma unroll
                    for (int hf = 0; hf < 2; ++hf) { float f[8];
#pragma unroll
                        for (int i = 0; i < 8; ++i) v[8 * hf + i] = ALPHA * x1[8 * hf + i];
#pragma unroll
                        for (int k = 0; k < 4; ++k) { unpack8_f8(yr[j][k][hf], f);
#pragma unroll
                            for (int i = 0; i < 8; ++i) v[8 * hf + i] += gt[j][k] * f[i]; } }
                    ln_row16(v, lng, lnb, lane, o[j]);
                }
#pragma unroll
                for (int j = 0; j < 2; ++j) {
                    const int t = tt[j];
                    if (layer == DEPTH - 1) {
#pragma unroll
                        for (int hf = 0; hf < 2; ++hf) { float* op = OUTo + (size_t)t * D + 512 * hf + 8 * lane;
                            *(f32x4*)op = (f32x4){o[j][8 * hf], o[j][8 * hf + 1], o[j][8 * hf + 2], o[j][8 * hf + 3]}; *(f32x4*)(op + 4) = (f32x4){o[j][8 * hf + 4], o[j][8 * hf + 5], o[j][8 * hf + 6], o[j][8 * hf + 7]}; }
                    } else {
                        store_bf16_row16(o[j], XBo + (size_t)t * D, lane);
                        const float qs = q8_row16(o[j], XQo + (size_t)t * D, lane);
                        if (lane == 0) SXo[t] = qs;
                    }
                }
#pragma unroll
                for (int j = 0; j < 2; ++j) { xr[j][0] = xrn[j][0]; xr[j][1] = xrn[j][1];
#pragma unroll
                    for (int k = 0; k < 4; ++k) { yr[j][k][0] = yrn[j][k][0]; yr[j][k][1] = yrn[j][k][1]; gt[j][k] = gn[j][k]; } }
            }
            }
        }
        if (layer + 1 < DEPTH) SEAM(P + 6);
    }
#undef IN
#undef SEAM
}

extern "C" void kernel_launch(void* const* d_in, const int* in_sizes, int n_in, void* d_out, int out_size, void* d_ws, size_t ws_size, hipStream_t stream) {
    static int grid = 0;
    if (grid == 0) {
        if (n_in != 17 || out_size != T * D || ws_size < WS_END) { fprintf(stderr, "kernel_launch: unexpected shapes (n_in %d, out %d, ws %zu)\n", n_in, out_size, ws_size); grid = -1; return; }
        int dev = 0, cus = 0;
        if (hipGetDevice(&dev) != hipSuccess || hipDeviceGetAttribute(&cus, hipDeviceAttributeMultiprocessorCount, dev) != hipSuccess) { grid = -1; return; }
        if (hipFuncSetAttribute((const void*)mk_fwd, hipFuncAttributeMaxDynamicSharedMemorySize, LDS_BYTES) != hipSuccess) { fprintf(stderr, "kernel_launch: hipFuncSetAttribute failed\n"); grid = -1; return; }
        int per_cu = 0;
        if (hipOccupancyMaxActiveBlocksPerMultiprocessor(&per_cu, (const void*)mk_fwd, NWAVES * 64, LDS_BYTES) != hipSuccess || per_cu < 1) fprintf(stderr, "kernel_launch: occupancy query reports %d\n", per_cu);
        (void)hipGetLastError();
        grid = cus;
        if (grid < 64) { fprintf(stderr, "kernel_launch: needs >= 64 CUs\n"); grid = -1; return; }
    }
    if (grid < 0) return;
    (void)hipMemsetAsync((char*)d_ws + WS_CTL, 0, CTL_ZERO_BYTES, stream);
    Args a{};
    for (int i = 0; i < 17; ++i) a.in[i] = (const float*)d_in[i];
    a.out = (float*)d_out; a.ws = (unsigned char*)d_ws;
#if MK_N_LAUNCHES == 1
    a.ph_lo = 0; a.ph_hi = N_PHASES;
    hipLaunchKernelGGL(mk_fwd, dim3(grid), dim3(NWAVES * 64), LDS_BYTES, stream, a);
#else
    for (int p = 0; p < N_PHASES; ++p) { a.ph_lo = p; a.ph_hi = p + 1; hipLaunchKernelGGL(mk_fwd, dim3(grid), dim3(NWAVES * 64), LDS_BYTES, stream, a); }
#endif
}
```

```cpp
#include <hip/hip_runtime.h>
#include <cstdio>
#include <cstdint>
#include <type_traits>

#ifndef MK_N_LAUNCHES
#define MK_N_LAUNCHES 1
#endif

#ifndef PROBE_REP_PH
#define PROBE_REP_PH (-1)
#endif
#define NREP(k) ((PROBE_REP_PH == (k)) ? 2 : 1)
#define LAS __attribute__((address_space(3)))
typedef unsigned short bf16_t;
typedef short bf16x8 __attribute__((ext_vector_type(8)));
typedef float f32x4 __attribute__((ext_vector_type(4)));
typedef unsigned u32x4 __attribute__((ext_vector_type(4)));
typedef unsigned u32x2 __attribute__((ext_vector_type(2)));
typedef int i32x4 __attribute__((ext_vector_type(4)));
typedef int i32x8 __attribute__((ext_vector_type(8)));

constexpr int BATCH = 16, SEQ = 2048, D = 1024, T = BATCH * SEQ, DEPTH = 4;
constexpr int EVEN_IN = 2048, ODD_IN = 2304, NEXP = 32, TOPK = 4;
constexpr float ALPHA = 1.6817928305074292f;
constexpr float LN_EPS = 1e-5f;
constexpr int NWAVES = 8;
constexpr int PH_PER_LAYER = 7, N_PHASES = 1 + DEPTH * PH_PER_LAYER;

constexpr size_t MiB = 1u << 20;
constexpr size_t WS_CTL = 0, CTL_ZERO_BYTES = 64 * 1024;
constexpr size_t WS_EVIN = 2 * MiB;
constexpr size_t WS_EVOUT = 10 * MiB;
constexpr size_t WS_ODIN = 14 * MiB;
constexpr size_t WS_ODOUT = 24 * MiB;
constexpr size_t WS_WGU = 32 * MiB;
constexpr size_t WS_SB = 288 * MiB;
constexpr size_t WS_SBIN = 289 * MiB;
constexpr size_t WS_SX = 289 * MiB + 512 * 1024;
constexpr size_t WS_XQ = 290 * MiB;
constexpr size_t WS_SBD = 332 * MiB;
constexpr size_t WS_SXS = 326 * MiB;
constexpr size_t WS_WDN = 544 * MiB;
constexpr size_t WS_XB = 800 * MiB;
constexpr size_t WS_H = 864 * MiB;
constexpr size_t WS_CAT = 1008 * MiB;
constexpr size_t WS_Y = 1072 * MiB;
constexpr size_t WS_ACT = 1136 * MiB;
constexpr size_t WS_YS = 1408 * MiB;
constexpr size_t WS_LIST = 1680 * MiB;
constexpr size_t WS_INFO = 1684 * MiB;
constexpr size_t WS_END = 1688 * MiB;
constexpr int CW_BAR = 4096, CW_CNT = 8192;

constexpr int RING_BYTES = 131072;
constexpr int MISC_OFF = RING_BYTES;
constexpr int TAB_OFF = RING_BYTES + 64;
constexpr int LDS_BYTES = 147456;

typedef float f32x2_t __attribute__((ext_vector_type(2)));
typedef __bf16 bf16x2_t __attribute__((ext_vector_type(2)));
__device__ __forceinline__ unsigned cvt_pk_bf16(float lo, float hi) { const f32x2_t v = {lo, hi}; const bf16x2_t b = __builtin_convertvector(v, bf16x2_t); return __builtin_bit_cast(unsigned, b); }
__device__ __forceinline__ float bf_lo(unsigned w) { return __uint_as_float(w << 16); }
__device__ __forceinline__ float bf_hi(unsigned w) { return __uint_as_float(w & 0xffff0000u); }
__device__ __forceinline__ void unpack8(const u32x4 w, float (&f)[8]) { f[0] = bf_lo(w.x); f[1] = bf_hi(w.x); f[2] = bf_lo(w.y); f[3] = bf_hi(w.y); f[4] = bf_lo(w.z); f[5] = bf_hi(w.z); f[6] = bf_lo(w.w); f[7] = bf_hi(w.w); }
__device__ __forceinline__ void unpack8_f8(const u32x2 w, float (&f)[8]) {
    typedef float f32x2v __attribute__((ext_vector_type(2)));
    const f32x2v a = __builtin_amdgcn_cvt_pk_f32_fp8((int)w.x, false), b = __builtin_amdgcn_cvt_pk_f32_fp8((int)w.x, true), c = __builtin_amdgcn_cvt_pk_f32_fp8((int)w.y, false), d = __builtin_amdgcn_cvt_pk_f32_fp8((int)w.y, true);
    f[0] = a.x; f[1] = a.y; f[2] = b.x; f[3] = b.y; f[4] = c.x; f[5] = c.y; f[6] = d.x; f[7] = d.y;
}
__device__ __forceinline__ u32x4 pack8(const float (&f)[8]) { u32x4 o; o.x = cvt_pk_bf16(f[0], f[1]); o.y = cvt_pk_bf16(f[2], f[3]); o.z = cvt_pk_bf16(f[4], f[5]); o.w = cvt_pk_bf16(f[6], f[7]); return o; }
__device__ __forceinline__ int lane_id() { unsigned ones = ~0u; asm volatile("" : "+s"(ones)); return (int)__builtin_amdgcn_mbcnt_hi(ones, __builtin_amdgcn_mbcnt_lo(ones, 0u)); }
template <int O> __device__ __forceinline__ float xor_sw(float v) { return __int_as_float(__builtin_amdgcn_ds_swizzle(__float_as_int(v), 0x1f | (O << 10))); }
__device__ __forceinline__ float sum_x32(float v) { const auto r = __builtin_amdgcn_permlane32_swap(__float_as_uint(v), __float_as_uint(v), false, false); return __uint_as_float(r[0]) + __uint_as_float(r[1]); }
__device__ __forceinline__ float max_x32(float v) { const auto r = __builtin_amdgcn_permlane32_swap(__float_as_uint(v), __float_as_uint(v), false, false); return fmaxf(__uint_as_float(r[0]), __uint_as_float(r[1])); }
template <int CTRL> __device__ __forceinline__ float dpp_f(float v) { return __int_as_float(__builtin_amdgcn_update_dpp(0, __float_as_int(v), CTRL, 0xf, 0xf, true)); }
__device__ __forceinline__ float wave_sum(float v) { v += dpp_f<0xB1>(v); v += dpp_f<0x4E>(v); v += dpp_f<0x141>(v); v += dpp_f<0x140>(v); v += xor_sw<16>(v); return sum_x32(v); }
__device__ __forceinline__ float wave_max(float v) { v = fmaxf(v, dpp_f<0xB1>(v)); v = fmaxf(v, dpp_f<0x4E>(v)); v = fmaxf(v, dpp_f<0x141>(v)); v = fmaxf(v, dpp_f<0x140>(v)); v = fmaxf(v, xor_sw<16>(v)); return max_x32(v); }
__device__ __forceinline__ unsigned q8x4(float a, float b, float c, float d, float inv) {
    const unsigned t0 = __float_as_uint(__builtin_fmaf(a, inv, 12582912.0f)), t1 = __float_as_uint(__builtin_fmaf(b, inv, 12582912.0f));
    const unsigned t2 = __float_as_uint(__builtin_fmaf(c, inv, 12582912.0f)), t3 = __float_as_uint(__builtin_fmaf(d, inv, 12582912.0f));
    return __builtin_amdgcn_perm(__builtin_amdgcn_perm(t3, t2, 0x0c0c0400u), __builtin_amdgcn_perm(t1, t0, 0x0c0c0400u), 0x05040100u);
}
__device__ __forceinline__ unsigned f8x4(float a, float b, float c, float d, float inv) {
    int w = __builtin_amdgcn_cvt_pk_fp8_f32(a * inv, b * inv, 0, false); w = __builtin_amdgcn_cvt_pk_fp8_f32(c * inv, d * inv, w, true); return (unsigned)w;
}
#define XB_TMO      128
#define XB_XCNT(j)  (256  + 64 * (j))
#define XB_XSUB(j)  (1280 + 64 * (j))
#define XB_XGEN(j)  (2304 + 64 * (j))
#define XB_TOP      3328
#define XB_TOPGEN   3392
#define XCD_BAR_WORDS 3456
#define XB_SPIN_CAP (1u << 18)

__device__ __forceinline__ unsigned xb_ld(unsigned* p)              { return __hip_atomic_load(p, __ATOMIC_RELAXED, __HIP_MEMORY_SCOPE_AGENT); }
__device__ __forceinline__ unsigned xb_add(unsigned* p, unsigned v) { return __hip_atomic_fetch_add(p, v, __ATOMIC_RELAXED, __HIP_MEMORY_SCOPE_AGENT); }
__device__ __forceinline__ unsigned xb_xcc_id() { return (unsigned)__builtin_amdgcn_s_getreg((3 << 11) | 20) & 0xFu; }
#define XB_SPIN(cond, bar) do { unsigned _sp = 0; while (cond) { __builtin_amdgcn_s_sleep(1); \
    if ((++_sp & 255u) == 0u) { if (xb_ld(&(bar)[XB_TMO])) break; if (_sp > XB_SPIN_CAP) { atomicAdd(&(bar)[XB_TMO], 1u); break; } } } } while (0)

struct XcdBarrier { unsigned* bar; unsigned x; volatile LAS unsigned* st; };

__device__ __forceinline__ XcdBarrier xcd_barrier_post(unsigned* bar, volatile LAS unsigned* st) {
    XcdBarrier b; b.bar = bar; b.x = xb_xcc_id(); b.st = st;
    if (threadIdx.x == 0) (void)xb_add(&bar[XB_XCNT(b.x)], 1u);
    return b;
}
__device__ __forceinline__ void xcd_barrier_complete(unsigned* bar, unsigned x, unsigned& nloc, unsigned& nx) {
    const unsigned G = gridDim.x * gridDim.y * gridDim.z;
    unsigned sum, cnt, mine, sp = 0u;
    for (;;) {
        sum = 0u; cnt = 0u; mine = 0u;
#pragma unroll
        for (unsigned j = 0; j < 16; ++j) { const unsigned c = xb_ld(&bar[XB_XCNT(j)]); sum += c; cnt += (c > 0u) ? 1u : 0u; mine = (j == x) ? c : mine; }
        if (sum == G) break;
        __builtin_amdgcn_s_sleep(1);
        if ((++sp & 255u) == 0u) { if (xb_ld(&bar[XB_TMO])) break; if (sp > XB_SPIN_CAP) { atomicAdd(&bar[XB_TMO], 1u); break; } }
    }
    nloc = mine > 0u ? mine : 1u; nx = cnt > 0u ? cnt : 1u;
}
__device__ __forceinline__ void xcd_barrier(const XcdBarrier& b, int wave_s) {
    asm volatile("s_waitcnt vmcnt(0)" ::: "memory");
    __syncthreads();
    if (wave_s == 0 && lane_id() == 0) {
        unsigned* bar = b.bar; asm volatile("" : "+s"(bar));
        const unsigned bx_ = xb_xcc_id();
        __builtin_amdgcn_s_waitcnt(0);
        unsigned nloc = b.st[0], nx = b.st[1];
        if (nloc == 0u) { xcd_barrier_complete(bar, bx_, nloc, nx); b.st[0] = nloc; b.st[1] = nx; }
        const unsigned old = xb_add(&bar[XB_XSUB(bx_)], 1u);
        const unsigned gen = old / nloc;
        if (old + 1u == (gen + 1u) * nloc) {
            __builtin_amdgcn_fence(__ATOMIC_RELEASE, "agent");
            asm volatile("s_waitcnt vmcnt(0)" ::: "memory");
            const unsigned og = xb_add(&bar[XB_TOP], 1u);
            const unsigned tg = og / nx;
            if (og + 1u == (tg + 1u) * nx) xb_add(&bar[XB_TOPGEN], 1u);
            else XB_SPIN(xb_ld(&bar[XB_TOPGEN]) == tg, bar);
            __builtin_amdgcn_fence(__ATOMIC_ACQUIRE, "agent");
            xb_add(&bar[XB_XGEN(bx_)], 1u);
            asm volatile("s_waitcnt vmcnt(0)" ::: "memory");
        } else {
            XB_SPIN(xb_ld(&bar[XB_XGEN(bx_)]) == gen, bar);
            __builtin_amdgcn_fence(__ATOMIC_ACQUIRE, "agent");
            asm volatile("s_waitcnt vmcnt(0)" ::: "memory");
        }
    }
    __syncthreads();
}

namespace pg8 {
constexpr int BM = 256, BK = 64, HALF = 128, HTB = HALF * BK * 2, STAGE_BYTES = 8 * HTB, NXCD = 8, WGM = 8, K = 1024;
__device__ __forceinline__ int lds_byte(int r, int c) { const int st = (r >> 4) * 2 + (c >> 5), rr = r & 15, cc = c & 31, ob = rr * 64 + cc * 2; return st * 1024 + (ob ^ (((ob >> 9) & 1) << 5)); }
__device__ __forceinline__ void stage_rc(int b, int& R, int& C) { const int st = b / 1024, sb = b % 1024, swz = sb ^ (((sb >> 9) & 1) << 5); R = (st >> 1) * 16 + swz / 64; C = (st & 1) * 32 + (swz % 64) / 2; }
__device__ __forceinline__ int perm32(int rho) { const int n = rho >> 4, i = rho & 15; return 8 * (i >> 2) + 4 * n + (i & 3); }

struct Unit { int pm, pn, e, aux; };

template <bool I8_> struct DenseSched {
    static constexpr bool GATHER = false;
    static constexpr int RPB = I8_ ? 1024 : 2048;
    const char* A; const char* Bt; int nM, nN, nwg, G, c;
    __device__ __forceinline__ void init(const void* A_, const void* Bt_, int M, int N, int G_, int c_) { A = (const char*)A_; Bt = (const char*)Bt_; nM = M / BM; nN = N / BM; nwg = nM * nN; G = G_; c = c_; }
    __device__ __forceinline__ bool next(int i, Unit& u) const {
        const long L = (long)i * G + c; if (L >= nwg) return false;
        int wgid = (int)L; { const int q = nwg / NXCD, r = nwg % NXCD, xcd = wgid % NXCD, off = wgid / NXCD; wgid = (xcd < r ? xcd * (q + 1) : r * (q + 1) + (xcd - r) * q) + off; }
        const int nig = WGM * nN, gid = wgid / nig, fm = gid * WGM, gsz = (nM - fm) < WGM ? (nM - fm) : WGM;
        u.pm = fm + ((wgid % nig) % gsz); u.pn = (wgid % nig) / gsz; u.e = 0; u.aux = 0; return true;
    }
    __device__ __forceinline__ const char* aptr(const Unit& u) const { return A + (size_t)u.pm * (size_t)(BM * RPB); }
    __device__ __forceinline__ const char* bptr(const Unit& u) const { return Bt + (size_t)u.pn * (size_t)(BM * RPB); }
    __device__ __forceinline__ void gather(const Unit&, unsigned (&)[2][2], int) const {}
    __device__ __forceinline__ const int* list_src(const Unit&) const { return nullptr; }
    __device__ __forceinline__ void gather_lds(const Unit&, unsigned (&)[2][2], int, const LAS unsigned char*) const {}
};
template <bool GATHER_, bool I8_> struct MoeSched {
    static constexpr bool GATHER = GATHER_;
    static constexpr int RPB = I8_ ? 1024 : 2048;
    const char* A; const char* Bt; const int* list; const LAS int* tb; const LAS int* cn; int NN, total, G, vcu;
    __device__ __forceinline__ bool next(int i, Unit& u) const {
        const int L = i * G + vcu; if (L >= total) return false;
        const int mt = L / NN; u.pn = L - mt * NN; u.pm = mt;
        int e = 0;
        for (int j = 1; j < NEXP; ++j) e += (tb[j] <= mt) ? 1 : 0;
        u.e = e; u.aux = mt - tb[e]; return true;
    }
    __device__ __forceinline__ const char* aptr(const Unit& u) const { return GATHER ? A : A + (size_t)u.pm * (size_t)(BM * RPB); }
    __device__ __forceinline__ const char* bptr(const Unit& u) const { return Bt + ((size_t)u.e * NN + u.pn) * (size_t)(BM * RPB); }
    __device__ __forceinline__ const int* list_src(const Unit& u) const { return list + (size_t)u.e * T + u.aux * BM; }
    __device__ __forceinline__ void gather_lds(const Unit& u, unsigned (&g)[2][2], int tid, const LAS unsigned char* tokbuf) const {
        tid = (tid & ~63) | lane_id();
        const int c = cn[u.e] - u.aux * BM; const LAS int* tl = (const LAS int*)tokbuf;
#pragma unroll
        for (int i = 0; i < 2; ++i) { int R, C; stage_rc(tid * 16 + i * 8192, R, C);
#pragma unroll
            for (int h = 0; h < 2; ++h) { int r = h * HALF + R; r = r < c ? r : 0; g[h][i] = (unsigned)(tl[r] * RPB + C * 2); } }
    }
    __device__ __forceinline__ void gather(const Unit& u, unsigned (&g)[2][2], int tid) const {
        tid = (tid & ~63) | lane_id();
        const int c = cn[u.e];
#pragma unroll
        for (int i = 0; i < 2; ++i) { int R, C; stage_rc(tid * 16 + i * 8192, R, C);
#pragma unroll
            for (int h = 0; h < 2; ++h) { int slot = u.aux * BM + h * HALF + R; slot = slot < c ? slot : 0; const int tok = list[(size_t)u.e * T + slot]; g[h][i] = (unsigned)(tok * RPB + C * 2); } }
    }
};

template <int MODE  > struct EpiBf16 {
    static constexpr bool PERM = true, PREFETCH = (MODE == 3 || MODE == 0);
    __device__ __forceinline__ void prefetch(const Unit& u, LAS unsigned char* ebuf, int wid, int lane) const {
        if (MODE == 3) {
            if (wid == 1) __builtin_amdgcn_global_load_lds((const unsigned*)(bias + (size_t)u.e * D + 256 * u.pn + 4 * lane), (LAS unsigned*)(ebuf), 16, 0, 0);
            if (wid == 2) __builtin_amdgcn_global_load_lds((const unsigned*)(sb + (size_t)u.e * D + 256 * u.pn + 4 * lane), (LAS unsigned*)(ebuf + 1024), 16, 0, 0); }
        if (MODE == 0) {
            if (wid == 1) __builtin_amdgcn_global_load_lds((const unsigned*)(sb + 256 * u.pn + 4 * lane), (LAS unsigned*)(ebuf + 1024), 16, 0, 0);
            if (wid == 2) __builtin_amdgcn_global_load_lds((const unsigned*)(sa + 256 * u.pm + 4 * lane), (LAS unsigned*)(ebuf + 2048), 16, 0, 0); }
    }
    bf16_t* O; int ldc; const bf16_t* res; const float* bias; float alpha;
    const float* sa; const float* sb;
    __device__ __forceinline__ void operator()(const i32x4 (&acc)[2][2][4][2], const Unit& u, int wr, int wc, int fr, int fq, const LAS unsigned char* ebuf) const {
        { const int l2 = lane_id(); fr = l2 & 15; fq = l2 >> 4; }
        const int row0 = u.pm * BM + wr * 64 + fr, col0 = u.pn * BM + wc * 32 + 8 * fq;
        f32x4 sv[2][2];
#pragma unroll
        for (int bj = 0; bj < 2; ++bj)
#pragma unroll
            for (int n = 0; n < 2; ++n) sv[bj][n] = (MODE == 0) ? *(const LAS f32x4*)(ebuf + 1024 + 4 * (64 * wc + 16 * fq + 8 * bj + 4 * n)) : *(const f32x4*)(sb + col0 + bj * HALF + 4 * n);
        float rsv[2][4];
#pragma unroll
        for (int ai = 0; ai < 2; ++ai)
#pragma unroll
            for (int m = 0; m < 4; ++m) rsv[ai][m] = (MODE == 0) ? ((const LAS float*)ebuf)[512 + wr * 64 + fr + ai * HALF + m * 16] : sa[row0 + ai * HALF + m * 16];
#pragma unroll
        for (int ai = 0; ai < 2; ++ai)
#pragma unroll
            for (int m = 0; m < 4; ++m) { const int row = row0 + ai * HALF + m * 16; const float rs = rsv[ai][m]; const size_t ro = (size_t)row * ldc + col0;
#pragma unroll
                for (int bj = 0; bj < 2; ++bj) { float v[8];
#pragma unroll
                    for (int i = 0; i < 4; ++i) { v[i] = (float)acc[ai][bj][m][0][i] * (rs * sv[bj][0][i]); v[4 + i] = (float)acc[ai][bj][m][1][i] * (rs * sv[bj][1][i]); }
                    if (MODE == 0) *(u32x4*)(O + (size_t)row * ldc + u.pn * BM + 64 * wc + 16 * fq + 8 * bj) = pack8(v);
                    else *(u32x4*)(O + ro + bj * HALF) = pack8(v); } }
    }
    __device__ __forceinline__ void operator()(const f32x4 (&acc)[2][2][4][2], const Unit& u, int wr, int wc, int fr, int fq, const LAS unsigned char* ebuf) const {
        { const int l2 = lane_id(); fr = l2 & 15; fq = l2 >> 4; }
        const int row0 = u.pm * BM + wr * 64 + fr, col0 = u.pn * BM + wc * 32 + 8 * fq;
        f32x4 bv[2][2];
#pragma unroll
        for (int bj = 0; bj < 2; ++bj)
#pragma unroll
            for (int n = 0; n < 2; ++n) bv[bj][n] = (MODE == 3) ? *(const LAS f32x4*)(ebuf + 4 * (64 * wc + 16 * fq + 8 * bj + 4 * n)) * 16.0f
                                                  : (MODE == 2) ? *(const f32x4*)(bias + (size_t)u.e * D + col0 + bj * HALF + 4 * n) : (f32x4){0.f, 0.f, 0.f, 0.f};
        f32x4 cs[2][2];
#pragma unroll
        for (int bj = 0; bj < 2; ++bj)
#pragma unroll
            for (int n = 0; n < 2; ++n) cs[bj][n] = (MODE == 3) ? *(const LAS f32x4*)(ebuf + 1024 + 4 * (64 * wc + 16 * fq + 8 * bj + 4 * n))
                                                  : (MODE == 2) ? *(const f32x4*)(sb + (size_t)u.e * D + col0 + bj * HALF + 4 * n) : (f32x4){1.f, 1.f, 1.f, 1.f};
#pragma unroll
        for (int ai = 0; ai < 2; ++ai) {
            u32x4 rr[4][2];
            if (MODE == 1) {
#pragma unroll
                for (int m = 0; m < 4; ++m)
#pragma unroll
                    for (int bj = 0; bj < 2; ++bj) rr[m][bj] = *(const u32x4*)(res + (size_t)(row0 + ai * HALF + m * 16) * ldc + col0 + bj * HALF); }
#pragma unroll
            for (int m = 0; m < 4; ++m) { const size_t ro = (size_t)(row0 + ai * HALF + m * 16) * ldc + col0;
                u32x2 w8a;
#pragma unroll
                for (int bj = 0; bj < 2; ++bj) { f32x4 v0 = acc[ai][bj][m][0], v1 = acc[ai][bj][m][1];
                    if (MODE >= 2) { v0 = v0 * cs[bj][0]; v1 = v1 * cs[bj][1]; }
                    v0 += bv[bj][0]; v1 += bv[bj][1];
                    if (MODE == 1) { const u32x4 r = rr[m][bj];
                        v0[0] += alpha * bf_lo(r.x); v0[1] += alpha * bf_hi(r.x); v0[2] += alpha * bf_lo(r.y); v0[3] += alpha * bf_hi(r.y);
                        v1[0] += alpha * bf_lo(r.z); v1[1] += alpha * bf_hi(r.z); v1[2] += alpha * bf_lo(r.w); v1[3] += alpha * bf_hi(r.w); }
                    if (MODE == 3) { u32x2 w8; w8.x = f8x4(v0[0], v0[1], v0[2], v0[3], 1.0f); w8.y = f8x4(v1[0], v1[1], v1[2], v1[3], 1.0f);
                        if (bj == 0) w8a = w8;
                        else { u32x4 w16; w16.x = w8a.x; w16.y = w8a.y; w16.z = w8.x; w16.w = w8.y;
                            *(u32x4*)((unsigned char*)O + (size_t)(row0 + ai * HALF + m * 16) * ldc + u.pn * BM + 64 * wc + 16 * fq) = w16; } }
                    else { u32x4 w; w.x = cvt_pk_bf16(v0[0], v0[1]); w.y = cvt_pk_bf16(v0[2], v0[3]); w.z = cvt_pk_bf16(v1[0], v1[1]); w.w = cvt_pk_bf16(v1[2], v1[3]);
                        *(u32x4*)(O + ro + bj * HALF) = w; } } } }
    }
};
struct EpiSwiGLU {
    static constexpr bool PERM = false, PREFETCH = true;
    __device__ __forceinline__ void prefetch(const Unit& u, LAS unsigned char* ebuf, int wid, int lane) const {
        if (wid == 1) __builtin_amdgcn_global_load_lds((const unsigned*)(bias + (size_t)u.e * 2048 + 256 * u.pn + 4 * lane), (LAS unsigned*)(ebuf), 16, 0, 0);
        if (wid == 2) __builtin_amdgcn_global_load_lds((const unsigned*)(sb + (size_t)u.e * 2048 + 256 * u.pn + 4 * lane), (LAS unsigned*)(ebuf + 1024), 16, 0, 0);
        if (wid == 3) __builtin_amdgcn_global_load_lds((const unsigned*)(sxs + (size_t)u.e * T + u.aux * BM + 4 * lane), (LAS unsigned*)(ebuf + 2048), 16, 0, 0);
    }
    bf16_t* O; const float* bias;
    const float* sb; const float* sxs;
    __device__ __forceinline__ void operator()(const i32x4 (&acc)[2][2][4][2], const Unit& u, int wr, int wc, int fr, int fq, const LAS unsigned char* ebuf) const {
        { const int l2 = lane_id(); fr = l2 & 15; fq = l2 >> 4; }
        const int row0 = u.pm * BM + wr * 64 + fr;
        float rs[2][4];
#pragma unroll
        for (int ai = 0; ai < 2; ++ai)
#pragma unroll
            for (int m = 0; m < 4; ++m) rs[ai][m] = ((const LAS float*)ebuf)[512 + ai * HALF + wr * 64 + m * 16 + fr];
        int wst[2][4];
#pragma unroll
        for (int bj = 0; bj < 2; ++bj) {
            const int g32l = 4 * bj + wc, j0l = 32 * wc + 8 * fq + 4 * bj, j0 = 128 * u.pn + 32 * wc + 8 * fq;
            const f32x4 b0 = *(const LAS f32x4*)(ebuf + 8 * j0l), b1 = *(const LAS f32x4*)(ebuf + 8 * j0l + 16);
            const float bg[4] = {b0[0], b0[2], b1[0], b1[2]}, bl[4] = {b0[1] + 1.0f, b0[3] + 1.0f, b1[1] + 1.0f, b1[3] + 1.0f};
            const f32x4 sg = *(const LAS f32x4*)(ebuf + 1024 + 4 * (32 * g32l + 4 * fq)), sl = *(const LAS f32x4*)(ebuf + 1024 + 4 * (32 * g32l + 16 + 4 * fq));
            typedef float f32x2v __attribute__((ext_vector_type(2)));
            const f32x2v sg2[2] = {{sg[0], sg[1]}, {sg[2], sg[3]}}, sl2[2] = {{sl[0], sl[1]}, {sl[2], sl[3]}}, bg2[2] = {{bg[0], bg[1]}, {bg[2], bg[3]}}, bl2[2] = {{bl[0], bl[1]}, {bl[2], bl[3]}};
#pragma unroll
            for (int ai = 0; ai < 2; ++ai)
#pragma unroll
                for (int m = 0; m < 4; ++m) { float a[4]; const float rsm = rs[ai][m];
#pragma unroll
                    for (int h2 = 0; h2 < 2; ++h2) {
                        const f32x2v ga = {(float)acc[ai][bj][m][0][2 * h2], (float)acc[ai][bj][m][0][2 * h2 + 1]}, la = {(float)acc[ai][bj][m][1][2 * h2], (float)acc[ai][bj][m][1][2 * h2 + 1]};
                        f32x2v g = ga * (sg2[h2] * rsm) + bg2[h2], l = la * (sl2[h2] * rsm) + bl2[h2];
                        g.x = fminf(g.x, 7.0f); g.y = fminf(g.y, 7.0f); l.x = fminf(fmaxf(l.x, -6.0f), 8.0f); l.y = fminf(fmaxf(l.y, -6.0f), 8.0f);
                        const f32x2v z = g * (-1.702f * 1.4426950408889634f);
                        f32x2v den; den.x = __builtin_amdgcn_exp2f(z.x); den.y = __builtin_amdgcn_exp2f(z.y); den = den + 1.0f;
                        f32x2v r; r.x = __builtin_amdgcn_rcpf(den.x); r.y = __builtin_amdgcn_rcpf(den.y);
                        const f32x2v o = (g * r) * l;
                        a[2 * h2] = o.x; a[2 * h2 + 1] = o.y; }
                    int w = __builtin_amdgcn_cvt_pk_fp8_f32(a[0], a[1], 0, false); w = __builtin_amdgcn_cvt_pk_fp8_f32(a[2], a[3], w, true);
                    if (bj == 0) wst[ai][m] = w;
                    else { u32x2 w2; w2.x = (unsigned)wst[ai][m]; w2.y = (unsigned)w; *(u32x2*)((unsigned char*)O + (size_t)(row0 + ai * HALF + m * 16) * D + j0) = w2; } }
        }
    }
    __device__ __forceinline__ void operator()(const f32x4 (&acc)[2][2][4][2], const Unit& u, int wr, int wc, int fr, int fq, const LAS unsigned char* ebuf) const {
        { const int l2 = lane_id(); fr = l2 & 15; fq = l2 >> 4; }
        const int row0 = u.pm * BM + wr * 64 + fr;
#pragma unroll
        for (int bj = 0; bj < 2; ++bj) {
            const int j0 = 16 * (8 * u.pn + 4 * bj + wc) + 4 * fq;
            const f32x4 b0 = *(const f32x4*)(bias + (size_t)u.e * 2048 + 2 * j0), b1 = *(const f32x4*)(bias + (size_t)u.e * 2048 + 2 * j0 + 4);
            const float bg[4] = {b0[0], b0[2], b1[0], b1[2]}, bl[4] = {b0[1], b0[3], b1[1], b1[3]};
#pragma unroll
            for (int ai = 0; ai < 2; ++ai)
#pragma unroll
                for (int m = 0; m < 4; ++m) { float a[4];
#pragma unroll
                    for (int i = 0; i < 4; ++i) { float g = acc[ai][bj][m][0][i] + bg[i], l = acc[ai][bj][m][1][i] + bl[i];
                        g = fminf(g, 7.0f); l = fminf(fmaxf(l, -7.0f), 7.0f);
                        const float sg = __builtin_amdgcn_rcpf(1.0f + __expf(-1.702f * g));
                        a[i] = g * sg * (l + 1.0f); }
                    u32x2 w; w.x = cvt_pk_bf16(a[0], a[1]); w.y = cvt_pk_bf16(a[2], a[3]);
                    *(u32x2*)(O + (size_t)(row0 + ai * HALF + m * 16) * D + j0) = w; }
        }
    }
};

__device__ __forceinline__ f32x4 mma16(bf16x8 a, bf16x8 b, f32x4 c) { return __builtin_amdgcn_mfma_f32_16x16x32_bf16(a, b, c, 0, 0, 0); }
__device__ __forceinline__ i32x4 mma16(bf16x8 a, bf16x8 b, i32x4 c) { return __builtin_amdgcn_mfma_i32_16x16x64_i8(__builtin_bit_cast(i32x4, a), __builtin_bit_cast(i32x4, b), c, 0, 0, 0); }
struct NoHook { __device__ __forceinline__ void operator()(int) const {} };
template <int DT  , class Epi, class Sched, class Hook = NoHook>
__device__ __forceinline__ void gemm_phase(LAS unsigned char* lds, const Sched& S, const Epi& E, int wave_s, LAS unsigned char* aux  ,
                                           const Hook& H = Hook()  ) {
    constexpr bool GATHER = Sched::GATHER;
    constexpr int RPB = DT ? 1024 : 2048;
    typedef typename std::conditional<DT == 1, i32x4, f32x4>::type acc_t;
    int lane_ = lane_id(); asm volatile("" : "+v"(lane_));
    asm volatile("" : "+s"(wave_s));
    const int tid = wave_s * 64 + lane_;
    const int wid = wave_s, lane = tid & 63, wr = wid >> 2, wc = wid & 3, fr = lane & 15, fq = lane >> 4;
    constexpr int nt = RPB / 128;
    unsigned voffA[2], voffB[2];
#pragma unroll
    for (int i = 0; i < 2; ++i) { int R, C; stage_rc(tid * 16 + i * 8192, R, C); const int Rb = Epi::PERM ? ((R & ~31) + perm32(R & 31)) : R;
        voffA[i] = (unsigned)(R * RPB + C * 2); voffB[i] = (unsigned)(Rb * RPB + C * 2); }
    constexpr size_t kstep = (size_t)(BK * 2);
    constexpr size_t hstep = (size_t)HALF * RPB;
    const unsigned ldsw = (unsigned)wid * 1024u;
    const int aoff = lds_byte(wr * 64 + fr, fq * 8), boff = lds_byte(wc * 32 + fr, fq * 8);
    unsigned gA[2][2] = {{0u, 0u}, {0u, 0u}};
#define PG8_SA(b, h) (((b) * 2 + (h)) * HTB)
#define PG8_SB(b, h) ((4 + (b) * 2 + (h)) * HTB)
#define PG8_STAGE(bufoff, gbase, voff) do { _Pragma("unroll") for (int _i = 0; _i < 2; ++_i) \
        __builtin_amdgcn_global_load_lds((const unsigned*)((const char*)(gbase) + (voff)[_i]), (LAS unsigned*)(lds + (bufoff) + ldsw + _i * 8192), 16, 0, 0); } while (0)
#define PG8_STAGE_A(bufoff, h, abase) do { _Pragma("unroll") for (int _i = 0; _i < 2; ++_i) { \
        const char* _src = GATHER ? ((const char*)(abase) + gA[h][_i]) : ((const char*)(abase) + (size_t)(h) * hstep + voffA[_i]); \
        __builtin_amdgcn_global_load_lds((const unsigned*)_src, (LAS unsigned*)(lds + (bufoff) + ldsw + _i * 8192), 16, 0, 0); } } while (0)
#define PG8_LD2(dst, off) do { if constexpr (DT == 2) { const i32x4 _lo = *(const LAS i32x4*)(lds + (off)), _hi = *(const LAS i32x4*)(lds + (off) + 1024); (dst).f8 = __builtin_shufflevector(_lo, _hi, 0, 1, 2, 3, 4, 5, 6, 7); } \
        else { (dst).h[0] = *(const LAS bf16x8*)(lds + (off)); (dst).h[1] = *(const LAS bf16x8*)(lds + (off) + 1024); } } while (0)
#define PG8_LDA(dst, b, h) do { _Pragma("unroll") for (int m = 0; m < 4; ++m) PG8_LD2(dst[m], PG8_SA(b, h) + aoff + m * 2048); } while (0)
#define PG8_LDB(dst, b, h) do { _Pragma("unroll") for (int n = 0; n < 2; ++n) PG8_LD2(dst[n], PG8_SB(b, h) + boff + n * 2048); } while (0)
#define PG8_MMA(ai, bj, At, Bt) do { __builtin_amdgcn_s_setprio(1); _Pragma("unroll") for (int m = 0; m < 4; ++m) _Pragma("unroll") for (int n = 0; n < 2; ++n) { \
        if constexpr (DT == 2) acc[ai][bj][m][n] = __builtin_amdgcn_mfma_scale_f32_16x16x128_f8f6f4(Bt[n].f8, At[m].f8, acc[ai][bj][m][n], 0, 0, 0, 0x7f7f7f7f, 0, 0x7f7f7f7f); \
        else { _Pragma("unroll") for (int k = 0; k < 2; ++k) acc[ai][bj][m][n] = mma16(Bt[n].h[k], At[m].h[k], acc[ai][bj][m][n]); } \
        if constexpr (DT == 2) asm volatile("" : "+v"(acc[ai][bj][m][n]));   } \
        __builtin_amdgcn_s_setprio(0); } while (0)
#define PG8_WAIT_V(n) asm volatile("s_waitcnt vmcnt(" #n ")" ::: "memory")
#define PG8_WAIT_L(n) asm volatile("s_waitcnt lgkmcnt(" #n ")" ::: "memory")
#define PG8_BAR __builtin_amdgcn_s_barrier()
#define PG8_SCHED __builtin_amdgcn_sched_barrier(0)
    Unit cur, nxt; int ui = 0;
    if (!S.next(0, cur)) { H(-1); return; }
    acc_t acc[2][2][4][2];
#pragma unroll
    for (int a = 0; a < 2; ++a)
#pragma unroll
        for (int b = 0; b < 2; ++b)
#pragma unroll
            for (int m = 0; m < 4; ++m)
#pragma unroll
                for (int n = 0; n < 2; ++n) acc[a][b][m][n] = (acc_t){0, 0, 0, 0};
    struct Frag { bf16x8 h[2]; i32x8 f8; };
    Frag At[4], B0[2], B1[2];
    const char* cA = S.aptr(cur); const char* cB = S.bptr(cur);
    if (GATHER) S.gather(cur, gA, tid);
    PG8_STAGE(PG8_SB(0, 0), cB, voffB); PG8_STAGE(PG8_SB(0, 1), cB + hstep, voffB); PG8_STAGE_A(PG8_SA(0, 0), 0, cA); PG8_STAGE_A(PG8_SA(0, 1), 1, cA);
    if (wr == 1) PG8_BAR;
    PG8_WAIT_V(2); PG8_BAR;
    PG8_STAGE(PG8_SB(1, 0), cB + kstep, voffB); PG8_STAGE_A(PG8_SA(1, 0), 0, cA + kstep); PG8_STAGE(PG8_SB(1, 1), cB + hstep + kstep, voffB);
    PG8_WAIT_V(6); PG8_BAR;
    for (;;) {
        const bool has_next = S.next(ui + 1, nxt);
        const char* nA = has_next ? S.aptr(nxt) : cA; const char* nB = has_next ? S.bptr(nxt) : cB;
        {
            if constexpr (GATHER) { if (has_next && wid == 0) __builtin_amdgcn_global_load_lds((const unsigned*)(S.list_src(nxt) + 4 * lane), (LAS unsigned*)(aux + ((ui + 1) & 1) * 1024), 16, 0, 0); }
            if constexpr (Epi::PREFETCH) E.prefetch(cur, aux + 2048 + (ui & 1) * 3072, wid, lane);
        }
        for (int t = 0; t < nt; t += 2) {
            const bool last = (t == nt - 2);
            const char* a1 = cA + (size_t)(t + 1) * kstep;
            const char* a2 = last ? nA : cA + (size_t)(t + 2) * kstep; const char* b2 = last ? nB : cB + (size_t)(t + 2) * kstep;
            const char* a3 = a2 + kstep; const char* b3 = b2 + kstep;
            PG8_LDB(B0, 0, 0); PG8_LDB(B1, 0, 1); PG8_SCHED; PG8_LDA(At, 0, 0); PG8_STAGE_A(PG8_SA(1, 1), 1, a1);
            if (GATHER) { if (last && has_next) S.gather_lds(nxt, gA, tid, aux + ((ui + 1) & 1) * 1024); }
            PG8_WAIT_V(8); PG8_WAIT_L(0); PG8_BAR; PG8_MMA(0, 0, At, B0); PG8_MMA(0, 1, At, B1); PG8_BAR; PG8_SCHED;
            PG8_LDA(At, 0, 1); PG8_STAGE(PG8_SB(0, 0), b2, voffB); PG8_STAGE(PG8_SB(0, 1), b2 + hstep, voffB); PG8_STAGE_A(PG8_SA(0, 0), 0, a2);
            PG8_WAIT_V(8); PG8_WAIT_L(0); PG8_BAR; PG8_MMA(1, 0, At, B0); PG8_MMA(1, 1, At, B1); PG8_BAR; PG8_SCHED;
            PG8_LDB(B0, 1, 0); PG8_LDB(B1, 1, 1); PG8_SCHED; PG8_LDA(At, 1, 0); PG8_STAGE_A(PG8_SA(0, 1), 1, a2);
            PG8_WAIT_V(8); PG8_WAIT_L(0); PG8_BAR; PG8_MMA(0, 0, At, B0); PG8_MMA(0, 1, At, B1); PG8_BAR; PG8_SCHED;
            PG8_LDA(At, 1, 1); PG8_STAGE(PG8_SB(1, 0), b3, voffB); PG8_STAGE(PG8_SB(1, 1), b3 + hstep, voffB); PG8_STAGE_A(PG8_SA(1, 0), 0, a3);
            PG8_WAIT_V(8); PG8_WAIT_L(0); PG8_BAR; PG8_MMA(1, 0, At, B0); PG8_MMA(1, 1, At, B1); PG8_BAR; PG8_SCHED;
        }
        if (wr == 0) PG8_BAR;
        E(acc, cur, wr, wc, fr, fq, aux + 2048 + (ui & 1) * 3072);
        H(ui);
        if (!has_next) break;
#pragma unroll
        for (int a = 0; a < 2; ++a)
#pragma unroll
            for (int b = 0; b < 2; ++b)
#pragma unroll
                for (int m = 0; m < 4; ++m)
#pragma unroll
                    for (int n = 0; n < 2; ++n) acc[a][b][m][n] = (acc_t){0, 0, 0, 0};
        cur = nxt; cA = nA; cB = nB; ++ui;
        if (wr == 1) PG8_BAR;
    }
    PG8_WAIT_V(0);
    PG8_BAR;
    H(-1);
#undef PG8_SA
#undef PG8_SB
#undef PG8_STAGE
#undef PG8_STAGE_A
#undef PG8_LDA
#undef PG8_LDB
#undef PG8_MMA
#undef PG8_WAIT_V
#undef PG8_WAIT_L
#undef PG8_BAR
#undef PG8_SCHED
}
}

template <int MODE  >
__device__ __forceinline__ void tconv_item(const float* W, int N, bf16_t* Bt, int kb, int nb, int lane) {
    const int k0 = kb * 64, n = nb * 64 + lane;
    float v[64];
#pragma unroll
    for (int i = 0; i < 64; ++i) v[i] = W[(size_t)(k0 + i) * N + n];
    int row = n;
    if (MODE == 1) { const int j = n >> 1, par = n & 1; row = ((j >> 4) << 5) + (par << 4) + (j & 15); }
    u32x4* dst = (u32x4*)(Bt + (size_t)row * D + k0);
#pragma unroll
    for (int c = 0; c < 8; ++c) { u32x4 o; o.x = cvt_pk_bf16(v[8 * c], v[8 * c + 1]); o.y = cvt_pk_bf16(v[8 * c + 2], v[8 * c + 3]); o.z = cvt_pk_bf16(v[8 * c + 4], v[8 * c + 5]); o.w = cvt_pk_bf16(v[8 * c + 6], v[8 * c + 7]); dst[c] = o; }
}
template <bool PERMGL, bool FP8>
__device__ __forceinline__ void q8_cols_item(const float* W, int N, int n0, unsigned char* Bq, float* sc_out, LAS float* AM, int par, int wave, int lane) {
    const int n = n0 + lane;
    const float* Wp = W + (size_t)(128 * wave) * N + n;
    float v[128]; float am = 0.f;
#pragma unroll
    for (int i = 0; i < 128; ++i) v[i] = Wp[(size_t)i * N];
    __builtin_amdgcn_sched_barrier(0);
#pragma unroll
    for (int i = 0; i < 128; ++i) am = fmaxf(am, fabsf(v[i]));
    AM[(par * 8 + wave) * 64 + lane] = am;
    __syncthreads();
#pragma unroll
    for (int w = 0; w < 8; ++w) am = fmaxf(am, AM[(par * 8 + w) * 64 + lane]);
    const float sc = am > 0.f ? am * (FP8 ? (1.0f / 256.0f) : (1.0f / 127.0f)) : 1.0f, inv = 1.0f / sc;
    int row = n;
    if (PERMGL) { const int j = n >> 1, pr = n & 1, o = j & 127; row = ((j >> 7) << 8) + (((o >> 2) & 1) << 7) + ((o >> 5) << 5) + (pr << 4) + (((o >> 3) & 3) << 2) + (o & 3); }
    if (!PERMGL) { const int o = n & 255; row = ((n >> 8) << 8) + (((o >> 3) & 1) << 7) + ((o >> 6) << 5) + (((o >> 4) & 3) << 3) + (o & 7); }
    auto sel4 = [](bool c, const u32x4& a, const u32x4& b) { u32x4 r;
#pragma unroll
        for (int q = 0; q < 4; ++q) r[q] = c ? a[q] : b[q];
        return r; };
    auto x1 = [](const u32x4& x) { u32x4 r;
#pragma unroll
        for (int q = 0; q < 4; ++q) r[q] = (unsigned)__builtin_amdgcn_update_dpp(0, (int)x[q], 0xB1, 0xf, 0xf, true);
        return r; };
    auto x2 = [](const u32x4& x) { u32x4 r;
#pragma unroll
        for (int q = 0; q < 4; ++q) r[q] = (unsigned)__builtin_amdgcn_update_dpp(0, (int)x[q], 0x4E, 0xf, 0xf, true);
        return r; };
    const bool q0 = lane & 1, q1 = (lane >> 1) & 1;
    unsigned char* rb[4];
    { const int r0 = __builtin_amdgcn_update_dpp(0, row, 0x00, 0xf, 0xf, true), r1 = __builtin_amdgcn_update_dpp(0, row, 0x55, 0xf, 0xf, true),
                r2 = __builtin_amdgcn_update_dpp(0, row, 0xAA, 0xf, 0xf, true), r3 = __builtin_amdgcn_update_dpp(0, row, 0xFF, 0xf, 0xf, true);
      const int co = 128 * wave + 32 * (int)q1 + 16 * (int)q0;
      rb[0] = Bq + (size_t)r0 * 1024 + co; rb[1] = Bq + (size_t)r1 * 1024 + co; rb[2] = Bq + (size_t)r2 * 1024 + co; rb[3] = Bq + (size_t)r3 * 1024 + co; }
    auto packc = [&](int c) { u32x4 o;
        if (FP8) { o.x = f8x4(v[16 * c], v[16 * c + 1], v[16 * c + 2], v[16 * c + 3], inv); o.y = f8x4(v[16 * c + 4], v[16 * c + 5], v[16 * c + 6], v[16 * c + 7], inv);
                   o.z = f8x4(v[16 * c + 8], v[16 * c + 9], v[16 * c + 10], v[16 * c + 11], inv); o.w = f8x4(v[16 * c + 12], v[16 * c + 13], v[16 * c + 14], v[16 * c + 15], inv); }
        else { o.x = q8x4(v[16 * c], v[16 * c + 1], v[16 * c + 2], v[16 * c + 3], inv); o.y = q8x4(v[16 * c + 4], v[16 * c + 5], v[16 * c + 6], v[16 * c + 7], inv);
               o.z = q8x4(v[16 * c + 8], v[16 * c + 9], v[16 * c + 10], v[16 * c + 11], inv); o.w = q8x4(v[16 * c + 12], v[16 * c + 13], v[16 * c + 14], v[16 * c + 15], inv); }
        return o; };
#pragma unroll
    for (int G = 0; G < 2; ++G) { const u32x4 P0 = packc(4 * G), P1 = packc(4 * G + 1), P2 = packc(4 * G + 2), P3 = packc(4 * G + 3);
        const u32x4 own0 = sel4(q1, P2, P0), own1 = sel4(q1, P3, P1), oth0 = x2(sel4(q1, P0, P2)), oth1 = x2(sel4(q1, P1, P3));
        const u32x4 ro = x1(sel4(q0, own0, own1)), rt = x1(sel4(q0, oth0, oth1));
        const u32x4 dEo = sel4(q0, ro, own0), dOo = sel4(q0, own1, ro), dEt = sel4(q0, rt, oth0), dOt = sel4(q0, oth1, rt);
        *(u32x4*)(rb[0] + 64 * G) = sel4(q1, dEt, dEo); *(u32x4*)(rb[1] + 64 * G) = sel4(q1, dOt, dOo);
        *(u32x4*)(rb[2] + 64 * G) = sel4(q1, dEo, dEt); *(u32x4*)(rb[3] + 64 * G) = sel4(q1, dOo, dOt); }
    if (wave == 0) sc_out[PERMGL ? row : n] = FP8 ? sc * 16.0f : sc;
}
__device__ __forceinline__ void fold_item(const float* pool_w, const float* pool_scale, const float* w_out, bf16_t* BtOut, int item, int lane) {
    const int kq = item & 7, nb = (item >> 3) & 15, g = (item >> 7) & 3, i = item >> 9;
    const int n = nb * 64 + lane, kk0 = kq * 16;
    const float* pw = pool_w + ((size_t)(i * 4 + g) * 128 + kk0) * 128;
    const float* sc = pool_scale + i * 512 + g * 128;
    const float* wo = w_out + ((size_t)i * 1024 + g * 128) * D + n;
    float a0[16], a1[16];
    { const float s0 = sc[lane], s1 = sc[64 + lane];
#pragma unroll
      for (int k = 0; k < 16; ++k) { a0[k] = pw[k * 128 + lane] * s0; a1[k] = pw[k * 128 + 64 + lane] * s1; } }
    float acc[16];
#pragma unroll
    for (int k = 0; k < 16; ++k) acc[k] = 0.f;
#pragma unroll 8
    for (int c = 0; c < 64; ++c) { const float w0 = wo[(size_t)c * D], w1 = wo[(size_t)(c + 64) * D];
#pragma unroll
        for (int k = 0; k < 16; ++k) { acc[k] += __int_as_float(__builtin_amdgcn_readlane(__float_as_int(a0[k]), c)) * w0; acc[k] += __int_as_float(__builtin_amdgcn_readlane(__float_as_int(a1[k]), c)) * w1; } }
    u32x4* dst = (u32x4*)(BtOut + ((size_t)i * 1024 + n) * D + g * 128 + kk0);
    u32x4 o0, o1;
    o0.x = cvt_pk_bf16(acc[0], acc[1]); o0.y = cvt_pk_bf16(acc[2], acc[3]); o0.z = cvt_pk_bf16(acc[4], acc[5]); o0.w = cvt_pk_bf16(acc[6], acc[7]);
    o1.x = cvt_pk_bf16(acc[8], acc[9]); o1.y = cvt_pk_bf16(acc[10], acc[11]); o1.z = cvt_pk_bf16(acc[12], acc[13]); o1.w = cvt_pk_bf16(acc[14], acc[15]);
    dst[0] = o0; dst[1] = o1;
}

__device__ __forceinline__ bf16x8 ld16(const char* base, unsigned off) { return *(const bf16x8*)(base + off); }
struct TileD { int kb, d; float flim; bool valid; };
__device__ __forceinline__ void attn_load(const char* kp_base, const char* vp_base, const TileD& t_, bf16x8 (&kf)[2][2], bf16x8 (&vr)[4], int lane) {
    const int c = lane & 15, g = lane >> 4;
    TileD t = t_; asm volatile("" : "+s"(t.kb));
    if (!t.valid) {
#pragma unroll
        for (int j = 0; j < 4; ++j) { kf[j >> 1][j & 1] = (bf16x8){0, 0, 0, 0, 0, 0, 0, 0}; vr[j] = (bf16x8){0, 0, 0, 0, 0, 0, 0, 0}; }
        return; }
#pragma unroll
    for (int kt2 = 0; kt2 < 2; ++kt2) { const int kp = t.kb + t.d * (16 * kt2 + c);
        const unsigned off = (unsigned)kp * (unsigned)(ODD_IN * 2) + 16u * g;
        kf[kt2][0] = ld16(kp_base, off); kf[kt2][1] = ld16(kp_base, off + 64u); }
#pragma unroll
    for (int j = 0; j < 4; ++j) { const int ch = lane + 64 * j, row = ch >> 3, cc = ch & 7; const int kp = t.kb + t.d * row;
        vr[j] = ld16(vp_base, (unsigned)kp * (unsigned)(ODD_IN * 2) + 16u * cc); }
}
__device__ __forceinline__ void attn_vwrite(const bf16x8 (&vr)[4], LAS unsigned char* vbuf, int lane) {
#pragma unroll
    for (int j = 0; j < 4; ++j) { const int ch = lane + 64 * j; *(LAS bf16x8*)(vbuf + (ch >> 3) * 160 + (ch & 7) * 16) = vr[j]; }
}
typedef short s16x4 __attribute__((ext_vector_type(4)));
__device__ __forceinline__ void attn_vfrag(const LAS unsigned char* vbuf, bf16x8 (&vf)[4], int lane) {
    const LAS unsigned char* p = vbuf + (4 * (lane >> 4) + ((lane >> 2) & 3)) * 160 + 8 * (lane & 3);
#pragma unroll
    for (int mt = 0; mt < 4; ++mt) { const s16x4 a = __builtin_amdgcn_ds_read_tr16_b64_v4i16((LAS s16x4*)(p + 32 * mt)), b = __builtin_amdgcn_ds_read_tr16_b64_v4i16((LAS s16x4*)(p + 2560 + 32 * mt));
        vf[mt] = __builtin_shufflevector(a, b, 0, 1, 2, 3, 4, 5, 6, 7); }
}
template <int NH, class InitF>
__device__ __forceinline__ void attn_core(const bf16x8 (&kf)[2][2], const LAS unsigned char* vbuf, const InitF& initf  ,
                                          const bf16x8 (&bq)[NH][2], float (&m)[NH], float (&l)[NH], f32x4 (&O)[NH][4], int lane) {
    bf16x8 vf[4];
    attn_vfrag(vbuf, vf, lane);
#pragma unroll
    for (int hq = 0; hq < NH; ++hq) {
        f32x4 s0 = initf(hq, 0), s1 = initf(hq, 1);
        s0 = __builtin_amdgcn_mfma_f32_16x16x32_bf16(kf[0][0], bq[hq][0], s0, 0, 0, 0); s0 = __builtin_amdgcn_mfma_f32_16x16x32_bf16(kf[0][1], bq[hq][1], s0, 0, 0, 0);
        s1 = __builtin_amdgcn_mfma_f32_16x16x32_bf16(kf[1][0], bq[hq][0], s1, 0, 0, 0); s1 = __builtin_amdgcn_mfma_f32_16x16x32_bf16(kf[1][1], bq[hq][1], s1, 0, 0, 0);
        float mx = fmaxf(fmaxf(fmaxf(s0[0], s0[1]), fmaxf(s0[2], s0[3])), fmaxf(fmaxf(s1[0], s1[1]), fmaxf(s1[2], s1[3])));
        mx = fmaxf(mx, xor_sw<16>(mx)); mx = max_x32(mx);
        const float mn = fmaxf(m[hq], mx), corr = __builtin_amdgcn_exp2f(m[hq] - mn); m[hq] = mn;
        float p[8], ps = 0.f;
#pragma unroll
        for (int i = 0; i < 8; ++i) { p[i] = __builtin_amdgcn_exp2f((i < 4 ? s0[i & 3] : s1[i & 3]) - mn); ps += p[i]; }
        l[hq] = l[hq] * corr + ps;
        u32x4 pw; pw.x = cvt_pk_bf16(p[0], p[1]); pw.y = cvt_pk_bf16(p[2], p[3]); pw.z = cvt_pk_bf16(p[4], p[5]); pw.w = cvt_pk_bf16(p[6], p[7]);
        const bf16x8 pb = __builtin_bit_cast(bf16x8, pw);
        if (__builtin_amdgcn_ballot_w64(corr != 1.0f) != 0ull) {
#pragma unroll
            for (int mt = 0; mt < 4; ++mt) O[hq][mt] *= corr; }
#pragma unroll
        for (int mt = 0; mt < 4; ++mt) O[hq][mt] = __builtin_amdgcn_mfma_f32_16x16x32_bf16(vf[mt], pb, O[hq][mt], 0, 0, 0);
    }
}
template <int NH, class InitF>
__device__ __forceinline__ void attn_core64(const LAS unsigned char* kbuf  , const LAS unsigned char* vbuf  , const InitF& initf  ,
                                            const bf16x8 (&bq)[NH][2], float (&m)[NH], float (&l)[NH], f32x4 (&O)[NH][4], int lane) {
    const int c = lane & 15, g = lane >> 4;
    bf16x8 pb[NH][2]; float corr[NH];
#pragma unroll
    for (int hq = 0; hq < NH; ++hq) {
        f32x4 sa[4];
#pragma unroll
        for (int t = 0; t < 4; ++t) sa[t] = initf(hq, t);
#pragma unroll
        for (int t = 0; t < 4; ++t) { const bf16x8 k0 = *(const LAS bf16x8*)(kbuf + (16 * t + c) * 144 + 16 * g), k1 = *(const LAS bf16x8*)(kbuf + (16 * t + c) * 144 + 16 * g + 64);
            sa[t] = __builtin_amdgcn_mfma_f32_16x16x32_bf16(k0, bq[hq][0], sa[t], 0, 0, 0); sa[t] = __builtin_amdgcn_mfma_f32_16x16x32_bf16(k1, bq[hq][1], sa[t], 0, 0, 0); }
        float mx = -3.0e38f;
#pragma unroll
        for (int t = 0; t < 4; ++t) mx = fmaxf(mx, fmaxf(fmaxf(sa[t][0], sa[t][1]), fmaxf(sa[t][2], sa[t][3])));
        mx = fmaxf(mx, xor_sw<16>(mx)); mx = max_x32(mx);
        const float mn = fmaxf(m[hq], mx); corr[hq] = __builtin_amdgcn_exp2f(m[hq] - mn); m[hq] = mn;
        float p[16], ps = 0.f;
#pragma unroll
        for (int i = 0; i < 16; ++i) { p[i] = __builtin_amdgcn_exp2f(sa[i >> 2][i & 3] - mn); ps += p[i]; }
        l[hq] = l[hq] * corr[hq] + ps;
        u32x4 pw0, pw1;
        pw0.x = cvt_pk_bf16(p[0], p[1]); pw0.y = cvt_pk_bf16(p[2], p[3]); pw0.z = cvt_pk_bf16(p[4], p[5]); pw0.w = cvt_pk_bf16(p[6], p[7]);
        pw1.x = cvt_pk_bf16(p[8], p[9]); pw1.y = cvt_pk_bf16(p[10], p[11]); pw1.z = cvt_pk_bf16(p[12], p[13]); pw1.w = cvt_pk_bf16(p[14], p[15]);
        pb[hq][0] = __builtin_bit_cast(bf16x8, pw0); pb[hq][1] = __builtin_bit_cast(bf16x8, pw1);
    }
#pragma unroll
    for (int hq = 0; hq < NH; ++hq) {
        if (__builtin_amdgcn_ballot_w64(corr[hq] != 1.0f) != 0ull) {
#pragma unroll
            for (int mt = 0; mt < 4; ++mt) O[hq][mt] *= corr[hq]; } }
#pragma unroll
    for (int sb = 0; sb < 2; ++sb) { bf16x8 vf[4];
        attn_vfrag(vbuf + 5120 * sb, vf, lane);
#pragma unroll
        for (int hq = 0; hq < NH; ++hq)
#pragma unroll
            for (int mt = 0; mt < 4; ++mt) O[hq][mt] = __builtin_amdgcn_mfma_f32_16x16x32_bf16(vf[mt], pb[hq][sb], O[hq][mt], 0, 0, 0);
    }
}
template <int NH, int P, class Desc, class BiasF>
__device__ __forceinline__ void attn_unit(const char* kp_base, const char* vp_base, const Desc& dsc, int ntile, const BiasF& biasf, const bf16x8 (&bq)[NH][2],
                                          float (&m)[NH], float (&l)[NH], f32x4 (&O)[NH][4], LAS unsigned char* vl  , int lane) {
    constexpr int U = (P % 2 == 0) ? P : 2 * P;
    bf16x8 kf[P][2][2], vr[P][4];
#pragma unroll
    for (int s = 0; s < P; ++s) attn_load(kp_base, vp_base, dsc(s), kf[s], vr[s], lane);
    attn_vwrite(vr[0], vl, lane);
#pragma unroll 1
    for (int t0 = 0; t0 < ntile; t0 += U) {
#pragma unroll
        for (int u = 0; u < U; ++u) {
            const int t = t0 + u;
            attn_vwrite(vr[(u + 1) % P], vl + ((u + 1) & 1) * 5120, lane);
            const TileD td = dsc(t);
            if (td.valid) { const LAS unsigned char* bp[NH];
#pragma unroll
                for (int hq = 0; hq < NH; ++hq) bp[hq] = biasf(td, hq);
                auto initf = [&](int hq, int hh) { return *(const LAS f32x4*)(bp[hq] + 64 * hh); };
                attn_core<NH>(kf[u % P], vl + (u & 1) * 5120, initf, bq, m, l, O, lane); }
            attn_load(kp_base, vp_base, dsc(t + P), kf[u % P], vr[u % P], lane);
        }
    }
}
constexpr int SH_K = 0, SH_V = 9216, SH_BUF = 19456;
__device__ __forceinline__ bf16x8 attn_sh_load(const char* kp_base, const char* vp_base, int kb, int tid, int r) {
    kb = kb < 0 ? 0 : (kb > SEQ - 64 ? SEQ - 64 : kb);
    const int row = 32 * r + ((tid & 255) >> 3), cc = tid & 7; const int kp = kb + row;
    return ld16((tid >> 8) ? vp_base : kp_base, (unsigned)kp * (unsigned)(ODD_IN * 2) + 16u * cc);
}
__device__ __forceinline__ void attn_sh_write(bf16x8 v, LAS unsigned char* buf, int tid, int r) {
    const int row = 32 * r + ((tid & 255) >> 3), cc = tid & 7;
    *(LAS bf16x8*)(buf + ((tid >> 8) ? SH_V + row * 160 : SH_K + row * 144) + cc * 16) = v;
}
template <int NH, int NQ, bool TABLE>
__device__ __forceinline__ void attn_stream(const char* kp_base, const char* vp_base, int kb0, int ntile  , float flim, const float (&fqp)[NQ], const LAS unsigned char* const (&tab)[NQ], const float (&slope2)[NH], const bf16x8 (&bq)[NH][2],
                                            float (&m)[NH], float (&l)[NH], f32x4 (&O)[NH][4], LAS unsigned char* sh, int tid, int lane, int jlo, int jhi  ) {
    const int g = lane >> 4;
    int iq[NQ];
#pragma unroll
    for (int q = 0; q < NQ; ++q) iq[q] = 4 * g - (int)fqp[q];
    bf16x8 ra[2];
#pragma unroll
    for (int r = 0; r < 2; ++r) { ra[r] = attn_sh_load(kp_base, vp_base, kb0, tid, r); }
#pragma unroll
    for (int r = 0; r < 2; ++r) attn_sh_write(ra[r], sh, tid, r);
#pragma unroll
    for (int r = 0; r < 2; ++r) ra[r] = attn_sh_load(kp_base, vp_base, kb0 + 64, tid, r);
    __syncthreads();
    for (int j = 0; j < ntile; ++j) {
        const int kb = kb0 + 64 * j; LAS unsigned char* buf = sh + (j & 1) * SH_BUF;
        if (j >= jlo && j <= jhi && !(kb + 63 < 0 || kb >= SEQ)) {
            if constexpr (TABLE) {
                const LAS unsigned char* bp[NQ];
#pragma unroll
                for (int q = 0; q < NQ; ++q) bp[q] = tab[q] + 4 * kb;
                auto initf = [&](int hq, int t) { return *(const LAS f32x4*)(bp[hq] + 64 * t); };
                attn_core64<NH>(buf + SH_K, buf + SH_V, initf, bq, m, l, O, lane);
            } else {
                const float fb = (float)(kb + iq[0]);
                if (__builtin_amdgcn_ballot_w64(!(fabsf(fb) <= flim && fabsf(fb + 51.f) <= flim)) == 0ull) {
                    auto initf = [&](int hq, int t) { f32x4 v;
#pragma unroll
                        for (int r = 0; r < 4; ++r) v[r] = -slope2[hq] * fabsf(fb + (float)(16 * t + r));
                        return v; };
                    attn_core64<NH>(buf + SH_K, buf + SH_V, initf, bq, m, l, O, lane);
                } else {
                    auto initf = [&](int hq, int t) { f32x4 v;
#pragma unroll
                        for (int r = 0; r < 4; ++r) { const float ad = fabsf(fb + (float)(16 * t + r)); v[r] = __builtin_fmaf(-slope2[hq], ad, (ad <= flim) ? 0.f : -3.0e38f); }
                        return v; };
                    attn_core64<NH>(buf + SH_K, buf + SH_V, initf, bq, m, l, O, lane);
                }
            }
        }
#pragma unroll
        for (int r = 0; r < 2; ++r) attn_sh_write(ra[r], sh + ((j + 1) & 1) * SH_BUF, tid, r);
#pragma unroll
        for (int r = 0; r < 2; ++r) ra[r] = attn_sh_load(kp_base, vp_base, kb0 + 64 * (j + 2), tid, r);
        __syncthreads();
    }
}
template <int NH>
__device__ __forceinline__ void attn_store(bf16_t* orow  , const int (&ocol)[NH], const float (&l)[NH], const float (&extra)[NH], const f32x4 (&O)[NH][4], int lane) {
    const int g = lane >> 4;
#pragma unroll
    for (int hq = 0; hq < NH; ++hq) { float lt = l[hq]; lt += xor_sw<16>(lt); lt = sum_x32(lt); lt += extra[hq];
        const float inv = 1.0f / lt;
#pragma unroll
        for (int mt = 0; mt < 4; ++mt) { u32x2 w;
            w.x = cvt_pk_bf16(O[hq][mt][0] * inv, O[hq][mt][1] * inv); w.y = cvt_pk_bf16(O[hq][mt][2] * inv, O[hq][mt][3] * inv);
            *(u32x2*)(orow + ocol[hq] + 16 * mt + 4 * g) = w; } }
}
__device__ __forceinline__ bf16x8 q_prescale(bf16x8 q) {
    const u32x4 w = __builtin_bit_cast(u32x4, q); float f[8]; unpack8(w, f);
#pragma unroll
    for (int i = 0; i < 8; ++i) f[i] *= 0.18033688011112042f;
    return __builtin_bit_cast(bf16x8, pack8(f));
}
__device__ __forceinline__ void ln_row16(float (&v)[16], const float* lng, const float* lnb, int lane, float (&o)[16]) {
    const float s = ((v[0] + v[1]) + (v[2] + v[3])) + ((v[4] + v[5]) + (v[6] + v[7])) + (((v[8] + v[9]) + (v[10] + v[11])) + ((v[12] + v[13]) + (v[14] + v[15])));
    const float mean = wave_sum(s) * (1.0f / D);
#pragma unroll
    for (int i = 0; i < 16; ++i) v[i] -= mean;
    const float s2 = ((v[0] * v[0] + v[1] * v[1]) + (v[2] * v[2] + v[3] * v[3])) + ((v[4] * v[4] + v[5] * v[5]) + (v[6] * v[6] + v[7] * v[7]))
                   + (((v[8] * v[8] + v[9] * v[9]) + (v[10] * v[10] + v[11] * v[11])) + ((v[12] * v[12] + v[13] * v[13]) + (v[14] * v[14] + v[15] * v[15])));
    const float rstd = 1.0f / sqrtf(wave_sum(s2) * (1.0f / D) + LN_EPS);
#pragma unroll
    for (int hf = 0; hf < 2; ++hf) { const int col = 512 * hf + 8 * lane;
        const f32x4 g0 = *(const f32x4*)(lng + col), g1 = *(const f32x4*)(lng + col + 4), b0 = *(const f32x4*)(lnb + col), b1 = *(const f32x4*)(lnb + col + 4);
#pragma unroll
        for (int i = 0; i < 4; ++i) { o[8 * hf + i] = v[8 * hf + i] * rstd * g0[i] + b0[i]; o[8 * hf + 4 + i] = v[8 * hf + 4 + i] * rstd * g1[i] + b1[i]; } }
}
__device__ __forceinline__ float q8_row16(const float (&o)[16], unsigned char* qrow, int lane) {
    float am = 0.f;
#pragma unroll
    for (int i = 0; i < 16; ++i) am = fmaxf(am, fabsf(o[i]));
    am = wave_max(am);
    const float qs = am > 0.f ? am * (1.0f / 127.0f) : 1.0f, qinv = 1.0f / qs;
#pragma unroll
    for (int hf = 0; hf < 2; ++hf) { u32x2 q; q.x = q8x4(o[8 * hf], o[8 * hf + 1], o[8 * hf + 2], o[8 * hf + 3], qinv); q.y = q8x4(o[8 * hf + 4], o[8 * hf + 5], o[8 * hf + 6], o[8 * hf + 7], qinv);
        *(u32x2*)(qrow + 512 * hf + 8 * lane) = q; }
    return qs;
}
__device__ __forceinline__ void store_bf16_row16(const float (&o)[16], bf16_t* row, int lane) {
#pragma unroll
    for (int hf = 0; hf < 2; ++hf) { const float (&oh)[8] = *(const float (*)[8])(o + 8 * hf); *(u32x4*)(row + 512 * hf + 8 * lane) = pack8(oh); }
}
struct Args { const float* in[17]; float* out; unsigned char* ws; int ph_lo, ph_hi; };

__global__ void __launch_bounds__(NWAVES * 64, 2) mk_fwd(Args args) {
    extern __shared__ __attribute__((aligned(16))) unsigned char lds_raw[];
    LAS unsigned char* lds = (LAS unsigned char*)lds_raw;
    const int G = gridDim.x, bx = blockIdx.x;
    const int wave_s = __builtin_amdgcn_readfirstlane(threadIdx.x >> 6);
    const int vcu = (G % 8 == 0) ? (bx % 8) * (G / 8) + bx / 8 : bx;
    const int NGW = G * NWAVES;
#define PHASE_IDS() int lane = lane_id(); asm volatile("" : "+v"(lane)); const int wave = wave_s, tid = wave_s * 64 + lane, gw = vcu * NWAVES + wave; (void)tid; (void)gw
    unsigned char* ws = args.ws;
    unsigned* ctl = (unsigned*)(ws + WS_CTL);
    bf16_t* XB = (bf16_t*)(ws + WS_XB); bf16_t* HB = (bf16_t*)(ws + WS_H); bf16_t* CAT = (bf16_t*)(ws + WS_CAT); bf16_t* YB = (bf16_t*)(ws + WS_Y);
    bf16_t* ACT = (bf16_t*)(ws + WS_ACT); bf16_t* YS = (bf16_t*)(ws + WS_YS); int* LIST = (int*)(ws + WS_LIST); i32x4* INFO = (i32x4*)(ws + WS_INFO);
    volatile LAS unsigned* MISC = (volatile LAS unsigned*)(lds + MISC_OFF);
    LAS int* CN = (LAS int*)(lds + TAB_OFF); LAS int* TB = (LAS int*)(lds + TAB_OFF + 128);
    if (threadIdx.x < 16) MISC[threadIdx.x] = 0u;
    __syncthreads();
#if MK_N_LAUNCHES == 1
    XcdBarrier bar = xcd_barrier_post(ctl + CW_BAR, MISC + 8);
#define GRID_BAR() xcd_barrier(bar, wave_s)
#else
#define GRID_BAR() do {} while (0)
#endif
#if MK_N_LAUNCHES == 1
#define IN(k) true
#define SEAM(k) GRID_BAR()
#else
    const int lo = args.ph_lo, hi = args.ph_hi;
#define IN(k) (lo <= (k) && (k) < hi)
#define SEAM(k) do {} while (0)
#endif

    for (int rep = 0; rep < NREP(7); ++rep) if (IN(0)) {
        PHASE_IDS();
        {
            LAS float* AM = (LAS float*)lds;
            int par = 0;
            for (int it = bx; it < 64 + 72; it += G, par ^= 1) {
                if (it < 64) { const int mi = it >> 5, nb = it & 31;
                    q8_cols_item<false, false>(args.in[1] + (size_t)mi * D * EVEN_IN, EVEN_IN, nb * 64, ws + WS_EVIN + (size_t)mi * EVEN_IN * 1024, (float*)(ws + WS_SBIN) + mi * EVEN_IN, AM, par, wave, lane); }
                else { const int r = it - 64, mi = r / 36, nb = r % 36;
                    q8_cols_item<false, false>(args.in[6] + (size_t)mi * D * ODD_IN, ODD_IN, nb * 64, ws + WS_ODIN + (size_t)mi * ODD_IN * 1024, (float*)(ws + WS_SBIN) + 16384 + mi * ODD_IN, AM, par, wave, lane); }
            }
            __syncthreads();
        }
        const float* ev_w_out = args.in[5]; const float* od_w_out = args.in[8];
        constexpr int I6 = 1024, I2 = 2 * 16 * 16, I3 = 2 * 8 * 16;
        constexpr int NITEMS = I6 + I2 + I3;
        for (int it = gw; it < NITEMS; it += NGW) {
            int r = __builtin_amdgcn_readfirstlane(it);
            if (r < I6) { fold_item(args.in[2], args.in[3], ev_w_out, (bf16_t*)(ws + WS_EVOUT), r, lane); continue; } r -= I6;
            if (r < I2) { const int mi = r / 256, q = r % 256; tconv_item<0>(od_w_out + (size_t)mi * D * D, D, (bf16_t*)(ws + WS_ODOUT) + (size_t)mi * D * D, q / 16, q % 16, lane); continue; } r -= I2;
            { const int mi = r / 128, q = r % 128; tconv_item<0>(ev_w_out + (size_t)mi * D * D, D, (bf16_t*)(ws + WS_EVOUT) + (size_t)mi * D * D, 8 + q / 16, q % 16, lane); }
        }
        const float* x = args.in[0];
        for (int t = gw; t < T; t += NGW) {
            float o[16];
#pragma unroll
            for (int hf = 0; hf < 2; ++hf) { const f32x4 a = *(const f32x4*)(x + (size_t)t * D + 512 * hf + 8 * lane), b = *(const f32x4*)(x + (size_t)t * D + 512 * hf + 8 * lane + 4);
#pragma unroll
                for (int i = 0; i < 4; ++i) { o[8 * hf + i] = a[i]; o[8 * hf + 4 + i] = b[i]; } }
            store_bf16_row16(o, XB + (size_t)t * D, lane);
            const float qs = q8_row16(o, ws + WS_XQ + (size_t)t * D, lane);
            if (lane == 0) ((float*)(ws + WS_SX))[t] = qs;
        }
    }
    SEAM(0);

    for (int layer = 0; layer < DEPTH; ++layer) {
        const int li = layer >> 1, odd = layer & 1, P = 1 + layer * PH_PER_LAYER;
        for (int rep = 0; rep < NREP(0); ++rep) if (IN(P + 0)) {
            pg8::DenseSched<true> S;
            if (odd) S.init(ws + WS_XQ, ws + WS_ODIN + (size_t)li * ODD_IN * 1024, T, ODD_IN, G, bx);
            else S.init(ws + WS_XQ, ws + WS_EVIN + (size_t)li * EVEN_IN * 1024, T, EVEN_IN, G, bx);
            pg8::EpiBf16<0> E{HB, odd ? ODD_IN : EVEN_IN, nullptr, nullptr, 0.f, (const float*)(ws + WS_SX), (const float*)(ws + WS_SBIN) + (odd ? 16384 + li * ODD_IN : li * EVEN_IN)};
            bool cv_fired = false;
            auto cv_hook = [&](int ui) {
                if (layer != 0 || cv_fired || (ui >= 0 && ui != ((bx >> 3) & 3))) return;
                cv_fired = true;
                LAS float* CAM = (LAS float*)(lds + RING_BYTES + 576 + 8192); const int lane_h = lane_id(); int par = 0;
#pragma unroll 1
                for (int r = bx; r < 1536; r += G, par ^= 1) {
                    if (r < 1024) { const int mi = r >> 5, nb = ((r & 31) + 8 * ((r >> 6) & 3)) & 31;
                        q8_cols_item<true, false>(args.in[11] + (size_t)mi * D * 2048, 2048, nb * 64, ws + WS_WGU + (size_t)mi * 2048 * 1024, (float*)(ws + WS_SB) + (size_t)mi * 2048, CAM, par, wave_s, lane_h); }
                    else { const int r2 = r - 1024, mi = r2 >> 4, nb = ((r2 & 15) + 8 * ((r2 >> 6) & 1)) & 15;
                        q8_cols_item<false, true>(args.in[13] + (size_t)mi * D * D, D, nb * 64, ws + WS_WDN + (size_t)mi * D * 1024, (float*)(ws + WS_SBD) + (size_t)mi * D, CAM, par, wave_s, lane_h); } }
                __syncthreads();
            };
            pg8::gemm_phase<1>(lds, S, E, wave_s, lds + RING_BYTES + 576, cv_hook);
        }
        SEAM(P + 0);
        for (int rep = 0; rep < NREP(1); ++rep) if (IN(P + 1)) {
            PHASE_IDS();
            if (!odd) {
                const float* conv_w = args.in[4] + (size_t)li * 3 * 512;
                for (int task = gw; task < 2048; task += NGW) {
                    const int run = task >> 1, kind = task & 1, b = run >> 6, t0 = (run & 63) * 32;
                    const bf16_t* hb = HB + (size_t)b * SEQ * EVEN_IN; bf16_t* cb = CAT + (size_t)b * SEQ * D;
                    if (kind == 0) {
                        const int ch0 = 8 * lane, half = 1 << (lane >> 4);
                        const bf16_t* base = hb + ch0;
                        float sum[8];
#pragma unroll
                        for (int i = 0; i < 8; ++i) sum[i] = 0.f;
                        {   u32x4 r0[16];
#pragma unroll
                            for (int j = 0; j < 16; ++j) { int p = t0 + j - 8; p = p < 0 ? 0 : (p > SEQ - 1 ? SEQ - 1 : p); r0[j] = *(const u32x4*)(base + (size_t)p * EVEN_IN); }
                            __builtin_amdgcn_sched_barrier(0);
#pragma unroll
                            for (int j = 0; j < 16; ++j) { const int dp = j - 8, p = t0 + dp; const float fl = (dp >= -half && dp < half && p >= 0 && p < SEQ) ? 1.f : 0.f;
                                float f[8]; unpack8(r0[j], f);
#pragma unroll
                                for (int i = 0; i < 8; ++i) sum[i] += fl * f[i]; } }
                        for (int tc = t0; tc < t0 + 32; tc += 8) {
                            u32x4 ru[8], ra[8], rb[8];
#pragma unroll
                            for (int j = 0; j < 8; ++j) { const int t = tc + j, pa = (t + half < SEQ) ? t + half : SEQ - 1, pb = (t - half >= 0) ? t - half : 0;
                                ru[j] = *(const u32x4*)(base + (size_t)t * EVEN_IN); ra[j] = *(const u32x4*)(base + (size_t)pa * EVEN_IN); rb[j] = *(const u32x4*)(base + (size_t)pb * EVEN_IN); }
                            __builtin_amdgcn_sched_barrier(0);
#pragma unroll
                            for (int j = 0; j < 8; ++j) { const int t = tc + j;
                                const int wlo = (t - half) > 0 ? (t - half) : 0, whi = (t + half) < SEQ ? (t + half) : SEQ;
                                const float rc = 1.0f / (float)(whi - wlo), fa = (t + half < SEQ) ? 1.f : 0.f, fb = (t - half >= 0) ? 1.f : 0.f;
                                float u[8], o[8], f[8]; unpack8(ru[j], u);
#pragma unroll
                                for (int i = 0; i < 8; ++i) o[i] = sum[i] * rc - u[i];
                                *(u32x4*)(cb + (size_t)t * D + ch0) = pack8(o);
                                unpack8(ra[j], f);
#pragma unroll
                                for (int i = 0; i < 8; ++i) sum[i] += fa * f[i];
                                unpack8(rb[j], f);
#pragma unroll
                                for (int i = 0; i < 8; ++i) sum[i] -= fb * f[i]; }
                        }
                    } else {
                        const int ch0 = 8 * lane;
                        float w0[8], w1[8], w2[8];
                        { const f32x4 a0 = *(const f32x4*)(conv_w + ch0), a1 = *(const f32x4*)(conv_w + ch0 + 4), b0 = *(const f32x4*)(conv_w + 512 + ch0), b1 = *(const f32x4*)(conv_w + 512 + ch0 + 4),
                                      c0 = *(const f32x4*)(conv_w + 1024 + ch0), c1 = *(const f32x4*)(conv_w + 1024 + ch0 + 4);
#pragma unroll
                          for (int i = 0; i < 4; ++i) { w0[i] = a0[i]; w0[4 + i] = a1[i]; w1[i] = b0[i]; w1[4 + i] = b1[i]; w2[i] = c0[i]; w2[4 + i] = c1[i]; } }
                        const bf16_t* pb = hb + 512 + ch0; const bf16_t* pc = hb + 1024 + ch0; const bf16_t* pv = hb + 1536 + ch0;
                        float up[8], uc[8], un[8];
#pragma unroll
                        for (int i = 0; i < 8; ++i) up[i] = 0.f;
                        if (t0 > 0) { float c[8], v[8]; unpack8(*(const u32x4*)(pc + (size_t)(t0 - 1) * EVEN_IN), c); unpack8(*(const u32x4*)(pv + (size_t)(t0 - 1) * EVEN_IN), v);
#pragma unroll
                            for (int i = 0; i < 8; ++i) up[i] = c[i] * v[i]; }
                        { float c[8], v[8]; unpack8(*(const u32x4*)(pc + (size_t)t0 * EVEN_IN), c); unpack8(*(const u32x4*)(pv + (size_t)t0 * EVEN_IN), v);
#pragma unroll
                            for (int i = 0; i < 8; ++i) uc[i] = c[i] * v[i]; }
                        for (int tc = t0; tc < t0 + 32; tc += 8) {
                            u32x4 rc_[8], rv_[8], rg_[8];
#pragma unroll
                            for (int j = 0; j < 8; ++j) { const int t = tc + j, pn = (t + 1 < SEQ) ? t + 1 : SEQ - 1;
                                rc_[j] = *(const u32x4*)(pc + (size_t)pn * EVEN_IN); rv_[j] = *(const u32x4*)(pv + (size_t)pn * EVEN_IN); rg_[j] = *(const u32x4*)(pb + (size_t)t * EVEN_IN); }
                            __builtin_amdgcn_sched_barrier(0);
#pragma unroll
                            for (int j = 0; j < 8; ++j) { const int t = tc + j; const float fn = (t + 1 < SEQ) ? 1.f : 0.f;
                                float c[8], v[8], bg[8], o[8]; unpack8(rc_[j], c); unpack8(rv_[j], v); unpack8(rg_[j], bg);
#pragma unroll
                                for (int i = 0; i < 8; ++i) { un[i] = fn * (c[i] * v[i]); o[i] = bg[i] * (up[i] * w0[i] + uc[i] * w1[i] + un[i] * w2[i]); up[i] = uc[i]; uc[i] = un[i]; }
                                *(u32x4*)(cb + (size_t)t * D + 512 + ch0) = pack8(o); }
                        }
                    }
                }
            } else {
                const float* sinkp = args.in[7] + li * 8;
                LAS unsigned char* vl = lds + wave * 10240;
                LAS unsigned char* sh = lds + 81920;
                const int c = lane & 15, g = lane >> 4;
                constexpr float LOG2E = 1.4426950408889634f;
                const int cv_first = layer, cv_n = (layer == 1) ? 2 * 1536 : 1536;
                int cv_it = bx, cv_par = 0, cv_done = 0;
                const int cv_mine = (cv_n - bx + G - 1) / G;
                const int n_bu = (2048 - bx + G - 1) / G;
                LAS float* CAM = (LAS float*)(lds + 120832);
                LAS float* TAB16 = (LAS float*)(lds + 124928);
                LAS float* TAB1 = (LAS float*)(lds + 131136);
                LAS float* TAB4 = (LAS float*)(lds + 141504);
                {   int hh = (bx >> 3) & 7; asm volatile("" : "+s"(hh));
                    const float sl2 = exp2f(-(float)(hh + 1)) * LOG2E;
                    for (int i = tid; i < 4 * 648; i += NWAVES * 64) { const int sft = i / 648, k = i - sft * 648; const float ad = fabsf((float)(k - sft - 320)); TAB1[i] = ad <= 64.f ? -sl2 * ad : -3.0e38f; }
                    for (int i = tid; i < 4 * 260; i += NWAVES * 64) { const int sft = i / 260, k = i - sft * 260; const float a1 = fabsf((float)(k - sft - 128));
                        TAB4[i] = 4.f * a1 <= 256.f ? -sl2 * 4.f * a1 : -3.0e38f; TAB16[i] = 16.f * a1 <= 1024.f ? -sl2 * 16.f * a1 : -3.0e38f; }
                    __syncthreads(); }
                int bu_idx = 0;
                for (int bu = bx; bu < 2048; bu += G, ++bu_idx) {
                    {   const int target = (bu_idx >= ((bx >> 3) % n_bu)) ? cv_mine : 0;
                        for (; cv_done < target; ++cv_done, cv_it += G, cv_par ^= 1) {
                            const int lyr = cv_first + cv_it / 1536, r = cv_it % 1536;
                            if (r < 1024) { const int mi = lyr * 32 + (r >> 5), nb = ((r & 31) + 8 * ((r >> 6) & 3)) & 31;
                                q8_cols_item<true, false>(args.in[11] + (size_t)mi * D * 2048, 2048, nb * 64, ws + WS_WGU + (size_t)mi * 2048 * 1024, (float*)(ws + WS_SB) + (size_t)mi * 2048, CAM, cv_par, wave, lane); }
                            else { const int r2 = r - 1024, mi = lyr * 32 + (r2 >> 4), nb = ((r2 & 15) + 8 * ((r2 >> 6) & 1)) & 15;
                                q8_cols_item<false, true>(args.in[13] + (size_t)mi * D * D, D, nb * 64, ws + WS_WDN + (size_t)mi * D * 1024, (float*)(ws + WS_SBD) + (size_t)mi * D, CAM, cv_par, wave, lane); }
                        }
                    }
                    int c_u = lane & 15, g_u = lane >> 4; asm volatile("" : "+v"(c_u), "+v"(g_u));
                    const int c = c_u, g = g_u;
                    if (bu < 1024) {
                        const int b = bu >> 6, h = (bu >> 3) & 7, ib = bu & 7;
                        const bf16_t* hb = HB + (size_t)b * SEQ * ODD_IN;
                        const char* kpb = (const char*)(hb + 512 + h * 64); const char* vpb = (const char*)(hb + 1024 + h * 64);
                        const float slope2[1] = {exp2f(-(float)(h + 1)) * LOG2E};
                        bf16x8 bq[2][2]; float m[2], l[2], fq2[2]; f32x4 O[2][4];
                        auto per_wave_part = [&](auto RR) { constexpr int rr = decltype(RR)::value;
                            const int rho = wave + 8 * rr, q0 = rho + 256 * ib, qp = q0 + 16 * c;
                            bf16x8 bq1[1][2];
                            { const bf16_t* qr = hb + (size_t)qp * ODD_IN + h * 64 + 8 * g; bq1[0][0] = q_prescale(*(const bf16x8*)qr); bq1[0][1] = q_prescale(*(const bf16x8*)(qr + 32)); }
                            float m1[1] = {-1e30f}, l1[1] = {0.f}; f32x4 O1[1][4];
#pragma unroll
                            for (int mt = 0; mt < 4; ++mt) O1[0][mt] = (f32x4){0.f, 0.f, 0.f, 0.f};
                            auto dsc = [&](int tl) { TileD t; t.kb = rho + 512 * tl; t.d = 16; t.flim = 1024.f;
                                t.valid = (tl < 4) && (512 * tl - 256 * ib - 240 <= 1024) && (256 * ib - 512 * tl - 496 <= 1024); return t; };
                            const LAS unsigned char* t16 = (const LAS unsigned char*)TAB16 + 1040 * (c & 3) + 4 * (128 + (c & 3) - 16 * ib - c + 4 * g);
                            auto bias16 = [&](const TileD& t, int) { return t16 + ((t.kb - rho) >> 2); };
                            attn_unit<1, 2>(kpb, vpb, dsc, 4, bias16, bq1, m1, l1, O1, vl, lane);
                            bq[rr][0] = bq1[0][0]; bq[rr][1] = bq1[0][1]; m[rr] = m1[0]; l[rr] = l1[0]; fq2[rr] = (float)qp;
#pragma unroll
                            for (int mt = 0; mt < 4; ++mt) O[rr][mt] = O1[0][mt];
                        };
                        per_wave_part(std::integral_constant<int, 0>{}); per_wave_part(std::integral_constant<int, 1>{});
                        const float slope22[2] = {slope2[0], slope2[0]};
                        {
                            const int kb4 = 256 * (ib - 1) + (wave & 3);
                            auto dsc4 = [&](int tl) { TileD t; t.kb = kb4 + 128 * tl; t.d = 4; t.flim = 256.f; t.valid = (tl < 6) && !(t.kb < 0 || t.kb >= SEQ); return t; };
                            const LAS unsigned char* t4[2];
#pragma unroll
                            for (int q = 0; q < 2; ++q) { const int s4 = ((wave >> 2) + 2 * q) & 3; t4[q] = (const LAS unsigned char*)TAB4 + 1040 * s4 + 4 * (128 + s4 - 64 - (wave >> 2) - 2 * q + 4 * g - 4 * c) - kb4; }
                            auto bias4 = [&](const TileD& t, int q) { return (q == 0 ? t4[0] : t4[1]) + t.kb; };
                            attn_unit<2, 2>(kpb, vpb, dsc4, 6, bias4, bq, m, l, O, vl, lane);
                        }
                        bf16x8 qraw[2][2];
#pragma unroll
                        for (int sl = 0; sl < 2; ++sl) { const bf16_t* qr = hb + (size_t)(256 * ib + 32 * wave + 16 * sl + c) * ODD_IN + h * 64 + 8 * g; qraw[sl][0] = *(const bf16x8*)qr; qraw[sl][1] = *(const bf16x8*)(qr + 32); }
                        __syncthreads();
                        {   LAS float* PARK = (LAS float*)lds;
#pragma unroll
                            for (int q = 0; q < 2; ++q) { float lt = l[q]; lt += xor_sw<16>(lt); lt = sum_x32(lt);
                                const int pp = wave + 8 * q + 16 * c;
#pragma unroll
                                for (int mt = 0; mt < 4; ++mt) *(LAS f32x4*)(PARK + pp * 68 + 4 * ((4 * mt + g) ^ c)) = O[q][mt];
                                if (g == 0) { PARK[pp * 68 + 64] = m[q]; PARK[pp * 68 + 65] = lt; } }
                            const LAS unsigned char* t1[2];
#pragma unroll
                            for (int sl = 0; sl < 2; ++sl) { const int qp = 256 * ib + 32 * wave + 16 * sl + c;
                                bq[sl][0] = q_prescale(qraw[sl][0]); bq[sl][1] = q_prescale(qraw[sl][1]);
                                m[sl] = -1e30f; l[sl] = 0.f; fq2[sl] = (float)qp;
#pragma unroll
                                for (int mt = 0; mt < 4; ++mt) O[sl][mt] = (f32x4){0.f, 0.f, 0.f, 0.f};
                                t1[sl] = (const LAS unsigned char*)TAB1 + 2592 * (c & 3) + 4 * (320 + (c & 3) + 4 * g - qp); }
                            attn_stream<2, 2, true>(kpb, vpb, 256 * ib - 64, 6, 64.f, fq2, t1, slope22, bq, m, l, O, sh, tid, lane, wave >> 1, (wave >> 1) + 2);
#pragma unroll
                            for (int sl = 0; sl < 2; ++sl) { const int pp = 32 * wave + 16 * sl + c, sw = (2 * wave + sl) & 15;
                                float lt = l[sl]; lt += xor_sw<16>(lt); lt = sum_x32(lt);
                                const float mc = PARK[pp * 68 + 64], lc = PARK[pp * 68 + 65];
                                const float mn = fmaxf(m[sl], mc), fa = __builtin_amdgcn_exp2f(m[sl] - mn), fb = __builtin_amdgcn_exp2f(mc - mn);
                                const float inv = 1.0f / (lt * fa + lc * fb);
                                bf16_t* orow = CAT + (size_t)(b * SEQ + 256 * ib + pp) * D + h * 64;
#pragma unroll
                                for (int mt = 0; mt < 4; ++mt) { const f32x4 oc = *(const LAS f32x4*)(PARK + pp * 68 + 4 * ((4 * mt + g) ^ sw)); const f32x4 v = (O[sl][mt] * fa + oc * fb) * inv;
                                    u32x2 w; w.x = cvt_pk_bf16(v[0], v[1]); w.y = cvt_pk_bf16(v[2], v[3]); *(u32x2*)(orow + 16 * mt + 4 * g) = w; } }
                        }
                        __syncthreads();
                    } else {
                        const int ud = bu - 1024, b = ud >> 6, kvh = (ud >> 5) & 1, qb = ud & 31;
                        const bf16_t* hb = HB + (size_t)b * SEQ * ODD_IN;
                        const int hp = wave & 1, q0 = 64 * qb + 16 * (wave >> 1), qp = q0 + c;
                        bf16x8 bq[2][2]; float m[2], l[2], slope2[2]; f32x4 O[2][4];
#pragma unroll
                        for (int j = 0; j < 2; ++j) { const int hq = 4 * kvh + 2 * hp + j; const bf16_t* qr = hb + (size_t)qp * ODD_IN + 1536 + hq * 64 + 8 * g;
                            bq[j][0] = q_prescale(*(const bf16x8*)qr); bq[j][1] = q_prescale(*(const bf16x8*)(qr + 32)); m[j] = -1e30f; l[j] = 0.f; slope2[j] = exp2f(-(float)(hq + 1)) * LOG2E;
#pragma unroll
                            for (int mt = 0; mt < 4; ++mt) O[j][mt] = (f32x4){0.f, 0.f, 0.f, 0.f}; }
                        const char* kpb = (const char*)(hb + 2048 + kvh * 64); const char* vpb = (const char*)(hb + 2176 + kvh * 64);
                        { const float fq1[1] = {(float)qp}; const LAS unsigned char* const notab[1] = {nullptr}; attn_stream<2, 1, false>(kpb, vpb, 64 * qb - 128, 5, 128.f, fq1, notab, slope2, bq, m, l, O, sh, tid, lane, 0, 4); }
                        int ocol[2]; float extra[2];
#pragma unroll
                        for (int j = 0; j < 2; ++j) { const int hq = 4 * kvh + 2 * hp + j; ocol[j] = 512 + hq * 64; extra[j] = __builtin_amdgcn_exp2f(sinkp[hq] * LOG2E - m[j]); }
                        attn_store<2>(CAT + (size_t)(b * SEQ + qp) * D, ocol, l, extra, O, lane);
                    }
                }
                __syncthreads();
            }
        }
        SEAM(P + 1);
        for (int rep = 0; rep < NREP(2); ++rep) if (IN(P + 2)) {
            pg8::DenseSched<false> S; S.init(CAT, odd ? (bf16_t*)(ws + WS_ODOUT) + (size_t)li * D * D : (bf16_t*)(ws + WS_EVOUT) + (size_t)li * D * D, T, D, G, bx);
            pg8::EpiBf16<1> E{YB, D, XB, nullptr, ALPHA, nullptr, nullptr};
            pg8::gemm_phase<0>(lds, S, E, wave_s, lds + RING_BYTES + 576);
        }
        SEAM(P + 2);
        if (IN(P + 3)) {
            PHASE_IDS();
            constexpr int XS = 1028;
            LAS float* XL = (LAS float*)lds;
            LAS float* PART = (LAS float*)(lds + 65792);
            LAS float* LOG = (LAS float*)(lds + 82176);
            LAS int* LCNT = (LAS int*)(lds + 84224);
            LAS int* GBASE = (LAS int*)(lds + 84352);
            LAS i32x4* REC = (LAS i32x4*)(lds + 84480);
            LAS float* TSC = (LAS float*)(lds + 122880);
            LAS float* TOP = (LAS float*)(lds + 124928);
            const float* lng = args.in[15] + (size_t)(layer * 2 + 0) * D; const float* lnb = args.in[16] + (size_t)(layer * 2 + 0) * D;
            const float* rw = args.in[9] + (size_t)layer * D * NEXP; const float* rb = args.in[10] + layer * NEXP;
            if (tid < 32) LCNT[tid] = 0;
            __syncthreads();
            const int tk = lane & 15, kq = lane >> 4;
            auto split8 = [](const float (&f)[8], bf16x8& hi, bf16x8& lo) { const u32x4 h = pack8(f); float fh[8], fl[8]; unpack8(h, fh);
#pragma unroll
                for (int i = 0; i < 8; ++i) fl[i] = f[i] - fh[i];
                hi = __builtin_bit_cast(bf16x8, h); lo = __builtin_bit_cast(bf16x8, pack8(fl)); };
            bf16x8 rwh[4][2], rwl[4][2];
#pragma unroll
            for (int ks = 0; ks < 4; ++ks)
#pragma unroll
                for (int tile = 0; tile < 2; ++tile) { float f[8];
#pragma unroll
                    for (int j = 0; j < 8; ++j) f[j] = rw[(size_t)(128 * wave + 32 * ks + 8 * kq + j) * NEXP + 16 * tile + tk];
                    split8(f, rwh[ks][tile], rwl[ks][tile]); }
            int nbatch = 0;
            for (int rep = 0; rep < NREP(3); ++rep) {
            const bool dummy = rep + 1 < NREP(3);
            bf16_t* XBo = dummy ? CAT : XB; unsigned char* XQo = dummy ? (unsigned char*)HB : ws + WS_XQ;
            if (rep > 0) { __syncthreads(); if (tid < 32) LCNT[tid] = 0; __syncthreads(); }
            nbatch = 0;
            u32x4 yp[2][2];
            {   const int b0 = bx < T / 16 ? bx : 0;
#pragma unroll
                for (int ii = 0; ii < 2; ++ii) { const size_t t = (size_t)b0 * 16 + wave * 2 + ii; yp[ii][0] = *(const u32x4*)(YB + t * D + 8 * lane); yp[ii][1] = *(const u32x4*)(YB + t * D + 512 + 8 * lane); } }
            for (int bi = bx; bi < T / 16; bi += G, ++nbatch) {
                u32x4 yc[2][2];
#pragma unroll
                for (int ii = 0; ii < 2; ++ii) { yc[ii][0] = yp[ii][0]; yc[ii][1] = yp[ii][1]; }
                {   const int bn = (bi + G < T / 16) ? bi + G : bi;
#pragma unroll
                    for (int ii = 0; ii < 2; ++ii) { const size_t t = (size_t)bn * 16 + wave * 2 + ii; yp[ii][0] = *(const u32x4*)(YB + t * D + 8 * lane); yp[ii][1] = *(const u32x4*)(YB + t * D + 512 + 8 * lane); } }
#pragma unroll
                for (int ii = 0; ii < 2; ++ii) {
                    const int tl = wave * 2 + ii, t = bi * 16 + tl;
                    float v[16], o[16];
#pragma unroll
                    for (int hf = 0; hf < 2; ++hf) { float f[8]; unpack8(yc[ii][hf], f);
#pragma unroll
                        for (int i = 0; i < 8; ++i) v[8 * hf + i] = f[i]; }
                    ln_row16(v, lng, lnb, lane, o);
#pragma unroll
                    for (int hf = 0; hf < 2; ++hf) { const int col = 512 * hf + 8 * lane;
                        *(LAS f32x4*)(XL + tl * XS + col) = (f32x4){o[8 * hf], o[8 * hf + 1], o[8 * hf + 2], o[8 * hf + 3]}; *(LAS f32x4*)(XL + tl * XS + col + 4) = (f32x4){o[8 * hf + 4], o[8 * hf + 5], o[8 * hf + 6], o[8 * hf + 7]}; }
                    const float qs = q8_row16(o, XQo + (size_t)t * D, lane);
                    if (lane == 0) TSC[nbatch * 16 + tl] = qs;
                }
                __syncthreads();
                {
                    f32x4 a0 = (f32x4){0.f, 0.f, 0.f, 0.f}, a1 = (f32x4){0.f, 0.f, 0.f, 0.f};
#pragma unroll
                    for (int ks = 0; ks < 4; ++ks) { const LAS float* xp = XL + tk * XS + 128 * wave + 32 * ks + 8 * kq; const f32x4 p = *(const LAS f32x4*)xp, q = *(const LAS f32x4*)(xp + 4);
                        const float f[8] = {p[0], p[1], p[2], p[3], q[0], q[1], q[2], q[3]}; bf16x8 xh, xl; split8(f, xh, xl);
                        a0 = __builtin_amdgcn_mfma_f32_16x16x32_bf16(xh, rwh[ks][0], a0, 0, 0, 0); a1 = __builtin_amdgcn_mfma_f32_16x16x32_bf16(xh, rwh[ks][1], a1, 0, 0, 0);
                        a0 = __builtin_amdgcn_mfma_f32_16x16x32_bf16(xh, rwl[ks][0], a0, 0, 0, 0); a1 = __builtin_amdgcn_mfma_f32_16x16x32_bf16(xh, rwl[ks][1], a1, 0, 0, 0);
                        a0 = __builtin_amdgcn_mfma_f32_16x16x32_bf16(xl, rwh[ks][0], a0, 0, 0, 0); a1 = __builtin_amdgcn_mfma_f32_16x16x32_bf16(xl, rwh[ks][1], a1, 0, 0, 0); }
#pragma unroll
                    for (int r = 0; r < 4; ++r) { PART[(wave * 16 + 4 * kq + r) * 32 + tk] = a0[r]; PART[(wave * 16 + 4 * kq + r) * 32 + 16 + tk] = a1[r]; }
                }
                __syncthreads();
                {   const int tq = tid >> 5, e = tid & 31; float s = rb[e];
#pragma unroll
                    for (int w = 0; w < 8; ++w) s += PART[(w * 16 + tq) * 32 + e];
                    const unsigned ub = __float_as_uint(s), key = (((ub >> 31) ? ~ub : (ub | 0x80000000u)) & ~31u) | (unsigned)(31 - e);
                    ((LAS unsigned*)LOG)[tq * 32 + e] = key;
                    asm volatile("s_waitcnt lgkmcnt(0)" ::: "memory");
                    int rank = 0;
#pragma unroll
                    for (int q = 0; q < 8; ++q) { const u32x4 t4 = *(const LAS u32x4*)((LAS unsigned*)LOG + tq * 32 + 4 * q);
#pragma unroll
                        for (int r = 0; r < 4; ++r) rank += (t4[r] > key) ? 1 : 0; }
                    if (rank < 4) TOP[tq * 4 + rank] = s;
                    asm volatile("s_waitcnt lgkmcnt(0)" ::: "memory");
                    if (rank < 4) {
                        const f32x4 tv = *(const LAS f32x4*)(TOP + tq * 4);
                        const float es = 1.0f + __expf(tv[1] - tv[0]) + __expf(tv[2] - tv[0]) + __expf(tv[3] - tv[0]);
                        const float wgt = __expf(s - tv[0]) * (1.0f / es);
                        const int lp = atomicAdd((int*)(LCNT + e), 1);
                        REC[(nbatch * 16 + tq) * 4 + rank] = (i32x4){e, lp, __float_as_int(wgt), bi * 16 + tq}; }
                }
            }
            }
            __syncthreads();
            if (tid < 32) { const int cc = LCNT[tid]; GBASE[tid] = cc ? (int)atomicAdd(ctl + CW_CNT + layer * 64 + tid, (unsigned)cc) : 0; }
            __syncthreads();
            for (int a = tid; a < nbatch * 64; a += NWAVES * 64) { const i32x4 r = REC[a]; const int pos = GBASE[r.x] + r.y;
                LIST[(size_t)r.x * T + pos] = r.w; ((float*)(ws + WS_SXS))[(size_t)r.x * T + pos] = TSC[a >> 2]; INFO[(size_t)r.w * 4 + (a & 3)] = (i32x4){r.x, pos, r.z, 0}; }
            __syncthreads();
        }
        SEAM(P + 3);
        if (IN(P + 4) || IN(P + 5) || IN(P + 6)) {
            PHASE_IDS();
            if (tid < 32) CN[tid] = (int)__hip_atomic_load(ctl + CW_CNT + layer * 64 + tid, __ATOMIC_RELAXED, __HIP_MEMORY_SCOPE_AGENT);
            __syncthreads();
            if (tid == 0) { int s = 0; for (int e = 0; e < 32; ++e) { TB[e] = s; s += (CN[e] + 255) >> 8; } TB[32] = s; }
            __syncthreads();
        }
        for (int rep = 0; rep < NREP(4); ++rep) if (IN(P + 4)) {
            pg8::MoeSched<true, true> S; S.A = (const char*)(ws + WS_XQ); S.Bt = (const char*)(ws + WS_WGU) + (size_t)layer * NEXP * 2048 * D; S.list = LIST; S.tb = TB; S.cn = CN; S.NN = 8; S.total = TB[32] * 8; S.G = G; S.vcu = vcu;
            pg8::EpiSwiGLU E{ACT, args.in[12] + (size_t)layer * NEXP * 2048, (const float*)(ws + WS_SB) + (size_t)layer * NEXP * 2048, (const float*)(ws + WS_SXS)};
            pg8::gemm_phase<1>(lds, S, E, wave_s, lds + RING_BYTES + 576);
        }
        SEAM(P + 4);
        for (int rep = 0; rep < NREP(5); ++rep) if (IN(P + 5)) {
            pg8::MoeSched<false, true> S; S.A = (const char*)ACT; S.Bt = (const char*)(ws + WS_WDN) + (size_t)layer * NEXP * D * 1024; S.list = LIST; S.tb = TB; S.cn = CN; S.NN = 4; S.total = TB[32] * 4; S.G = G; S.vcu = vcu;
            pg8::EpiBf16<3> E{YS, D, nullptr, args.in[14] + (size_t)layer * NEXP * D, 0.f, nullptr, (const float*)(ws + WS_SBD) + (size_t)layer * NEXP * D};
            pg8::gemm_phase<2>(lds, S, E, wave_s, lds + RING_BYTES + 576);
        }
        SEAM(P + 5);
        if (IN(P + 6)) {
            PHASE_IDS();
            const float* lng = args.in[15] + (size_t)(layer * 2 + 1) * D; const float* lnb = args.in[16] + (size_t)(layer * 2 + 1) * D;
            const float* lng1 = args.in[15] + (size_t)(layer * 2 + 0) * D; const float* lnb1 = args.in[16] + (size_t)(layer * 2 + 0) * D;
            for (int rep = 0; rep < NREP(6); ++rep) {
            const bool dummy = rep + 1 < NREP(6);
            bf16_t* XBo = dummy ? YB : XB; unsigned char* XQo = dummy ? (unsigned char*)CAT : ws + WS_XQ; float* SXo = dummy ? (float*)ACT : (float*)(ws + WS_SX); float* OUTo = dummy ? (float*)HB : args.out;
            auto tok_of = [&](int t0, int j) { return (j == 0 || t0 + NGW >= T) ? t0 : t0 + NGW; };
            auto load_raw = [&](int t0) { return INFO[(size_t)tok_of(t0, (lane >> 2) & 1) * 4 + (lane & 3)]; };
            auto unpack_raw = [&](const i32x4& raw, int (&e)[2][4], int (&p)[2][4], float (&gq)[2][4]) {
#pragma unroll
                for (int j = 0; j < 2; ++j)
#pragma unroll
                    for (int k = 0; k < 4; ++k) { e[j][k] = __builtin_amdgcn_readlane(raw.x, 4 * j + k); p[j][k] = __builtin_amdgcn_readlane(raw.y, 4 * j + k);
                        gq[j][k] = __int_as_float(__builtin_amdgcn_readlane(raw.z, 4 * j + k)) * (1.0f / 16.0f); } };
            auto load_rows = [&](int t0, const int (&e)[2][4], const int (&p)[2][4], u32x4 (&xr)[2][2], u32x2 (&yr)[2][4][2]) {
#pragma unroll
                for (int j = 0; j < 2; ++j) { const int t = tok_of(t0, j);
                    xr[j][0] = *(const u32x4*)(YB + (size_t)t * D + 8 * lane); xr[j][1] = *(const u32x4*)(YB + (size_t)t * D + 512 + 8 * lane);
#pragma unroll
                    for (int k = 0; k < 4; ++k) { const unsigned char* yp = (const unsigned char*)YS + ((size_t)TB[e[j][k]] * 256 + p[j][k]) * D;
                        yr[j][k][0] = *(const u32x2*)(yp + 8 * lane); yr[j][k][1] = *(const u32x2*)(yp + 512 + 8 * lane); } } };
            u32x4 xr[2][2], xrn[2][2]; u32x2 yr[2][4][2], yrn[2][4][2]; float gt[2][4];
            i32x4 raw = load_raw(gw);
            { int e0[2][4], p0[2][4]; unpack_raw(raw, e0, p0, gt); load_rows(gw, e0, p0, xr, yr); }
            raw = load_raw((gw + 2 * NGW < T) ? gw + 2 * NGW : gw);
            for (int t0 = gw; t0 < T; t0 += 2 * NGW) {
                int tt[2]; tt[0] = t0; tt[1] = tok_of(t0, 1);
                const int t1 = (t0 + 2 * NGW < T) ? t0 + 2 * NGW : t0, t2 = (t1 + 2 * NGW < T) ? t1 + 2 * NGW : t1;
                int en[2][4], pn[2][4]; float gn[2][4];
                unpack_raw(raw, en, pn, gn);
                load_rows(t1, en, pn, xrn, yrn);
                raw = load_raw(t2);
                __builtin_amdgcn_sched_barrier(0);
                float o[2][16];
#pragma unroll
                for (int j = 0; j < 2; ++j) {
                    float v[16], x1[16];
#pragma unroll
                    for (int hf = 0; hf < 2; ++hf) { float f[8]; unpack8(xr[j][hf], f);
#pragma unroll
                        for (int i = 0; i < 8; ++i) v[8 * hf + i] = f[i]; }
                    ln_row16(v, lng1, lnb1, lane, x1);
#pragma unroll
                    for (int hf = 0; hf < 2; ++hf) { float f[8];
#pragma unroll
                        for (int i = 0; i < 8; ++i) v[8 * hf + i] = ALPHA * x1[8 * hf + i];
#pragma unroll
                        for (int k = 0; k < 4; ++k) { unpack8_f8(yr[j][k][hf], f);
#pragma unroll
                            for (int i = 0; i < 8; ++i) v[8 * hf + i] += gt[j][k] * f[i]; } }
                    ln_row16(v, lng, lnb, lane, o[j]);
                }
#pragma unroll
                for (int j = 0; j < 2; ++j) {
                    const int t = tt[j];
                    if (layer == DEPTH - 1) {
#pragma unroll
                        for (int hf = 0; hf < 2; ++hf) { float* op = OUTo + (size_t)t * D + 512 * hf + 8 * lane;
                            *(f32x4*)op = (f32x4){o[j][8 * hf], o[j][8 * hf + 1], o[j][8 * hf + 2], o[j][8 * hf + 3]}; *(f32x4*)(op + 4) = (f32x4){o[j][8 * hf + 4], o[j][8 * hf + 5], o[j][8 * hf + 6], o[j][8 * hf + 7]}; }
                    } else {
                        store_bf16_row16(o[j], XBo + (size_t)t * D, lane);
                        const float qs = q8_row16(o[j], XQo + (size_t)t * D, lane);
                        if (lane == 0) SXo[t] = qs;
                    }
                }
#pragma unroll
                for (int j = 0; j < 2; ++j) { xr[j][0] = xrn[j][0]; xr[j][1] = xrn[j][1];
#pragma unroll
                    for (int k = 0; k < 4; ++k) { yr[j][k][0] = yrn[j][k][0]; yr[j][k][1] = yrn[j][k][1]; gt[j][k] = gn[j][k]; } }
            }
            }
        }
        if (layer + 1 < DEPTH) SEAM(P + 6);
    }
#undef IN
#undef SEAM
}

extern "C" void kernel_launch(void* const* d_in, const int* in_sizes, int n_in, void* d_out, int out_size, void* d_ws, size_t ws_size, hipStream_t stream) {
    static int grid = 0;
    if (grid == 0) {
        if (n_in != 17 || out_size != T * D || ws_size < WS_END) { fprintf(stderr, "kernel_launch: unexpected shapes (n_in %d, out %d, ws %zu)\n", n_in, out_size, ws_size); grid = -1; return; }
        int dev = 0, cus = 0;
        if (hipGetDevice(&dev) != hipSuccess || hipDeviceGetAttribute(&cus, hipDeviceAttributeMultiprocessorCount, dev) != hipSuccess) { grid = -1; return; }
        if (hipFuncSetAttribute((const void*)mk_fwd, hipFuncAttributeMaxDynamicSharedMemorySize, LDS_BYTES) != hipSuccess) { fprintf(stderr, "kernel_launch: hipFuncSetAttribute failed\n"); grid = -1; return; }
        int per_cu = 0;
        if (hipOccupancyMaxActiveBlocksPerMultiprocessor(&per_cu, (const void*)mk_fwd, NWAVES * 64, LDS_BYTES) != hipSuccess || per_cu < 1) fprintf(stderr, "kernel_launch: occupancy query reports %d\n", per_cu);
        (void)hipGetLastError();
        grid = cus;
        if (grid < 64) { fprintf(stderr, "kernel_launch: needs >= 64 CUs\n"); grid = -1; return; }
    }
    if (grid < 0) return;
    (void)hipMemsetAsync((char*)d_ws + WS_CTL, 0, CTL_ZERO_BYTES, stream);
    Args a{};
    for (int i = 0; i < 17; ++i) a.in[i] = (const float*)d_in[i];
    a.out = (float*)d_out; a.ws = (unsigned char*)d_ws;
#if MK_N_LAUNCHES == 1
    a.ph_lo = 0; a.ph_hi = N_PHASES;
    hipLaunchKernelGGL(mk_fwd, dim3(grid), dim3(NWAVES * 64), LDS_BYTES, stream, a);
#else
    for (int p = 0; p < N_PHASES; ++p) { a.ph_lo = p; a.ph_hi = p + 1; hipLaunchKernelGGL(mk_fwd, dim3(grid), dim3(NWAVES * 64), LDS_BYTES, stream, a); }
#endif
}
```
